# Optimizing an MI355X kernel written in HIP

```python
import jax, jax.numpy as jnp
from jax import lax
import numpy as np

D_MODEL = 1024
BATCH = 8
SEQ = 4096
DEPTH = 2
DEC_BATCH = 32
DEC_SEQ = 64
PAST_LEN = 1024

CHUNK = 64
HEAD_DIM = 64
H_A = 8
Q_LORA = 768
KV_LORA = 256
NOPE_DIM = 64
ROPE_DIM = 32
V_DIM = 64
ROPE_THETA = 10000.0
MLA_SCALE = (NOPE_DIM + ROPE_DIM) ** -0.5
H_B = 8
PREV_CHUNKS = 8
BAND_PAST = PREV_CHUNKS * CHUNK
REL_MAX = 256
N_REL = REL_MAX + CHUNK
BAND_SCALE = HEAD_DIM ** -0.5
H_C = 16
SB_SCALE = HEAD_DIM ** -0.5
Q_BLOCK = 128
IN_AB = Q_LORA + KV_LORA + ROPE_DIM + 3 * H_B * HEAD_DIM
MIX_AB = H_A * V_DIM + H_B * HEAD_DIM
IN_C = 3 * H_C * HEAD_DIM
MIX_C = H_C * HEAD_DIM
D_FF = 4 * D_MODEL
N_EVEN = (DEPTH + 1) // 2
N_ODD = DEPTH // 2
ALPHA = (2.0 * DEPTH) ** 0.25
BETA = (8.0 * DEPTH) ** -0.25
NEG_INF = -1e30

kernel_name = "hybrid_mla_band_stickbreak_stream_step"


def _layer_norm(x, g, b, eps=1e-5):
    xf = x.astype(jnp.float32)
    mu = jnp.mean(xf, -1, keepdims=True)
    var = jnp.mean(jnp.square(xf - mu), -1, keepdims=True)
    return ((xf - mu) * lax.rsqrt(var + eps) * g.astype(jnp.float32) + b.astype(jnp.float32)).astype(x.dtype)


def _rms_norm(x, g, eps=1e-6):
    xf = x.astype(jnp.float32)
    return (xf * lax.rsqrt(jnp.mean(jnp.square(xf), -1, keepdims=True) + eps) * g.astype(jnp.float32)).astype(x.dtype)


def _rope(x, pos):
    half = ROPE_DIM // 2
    inv = jnp.power(ROPE_THETA, -jnp.arange(half, dtype=jnp.float32) / half)
    ang = pos.astype(jnp.float32)[:, None] * inv[None, :]
    ang = ang.reshape((pos.shape[0],) + (1,) * (x.ndim - 3) + (half,))
    cos, sin = jnp.cos(ang), jnp.sin(ang)
    xf = x.astype(jnp.float32)
    x1, x2 = xf[..., :half], xf[..., half:]
    return jnp.concatenate([x1 * cos - x2 * sin, x2 * cos + x1 * sin], -1).astype(x.dtype)


def _chunk_mask(q_pos, k_pos):
    return (k_pos[None, :] // CHUNK) <= (q_pos[:, None] // CHUNK)


def _softmax_attend(q, k, v, mask, scale):
    s = jnp.einsum('bqhd,bkhd->bhqk', q, k).astype(jnp.float32) * scale
    p = jax.nn.softmax(jnp.where(mask, s, NEG_INF), axis=-1)
    return jnp.einsum('bhqk,bkhd->bqhd', p.astype(v.dtype), v)


def _stick_breaking(q, k, v, q_pos, k_pos):
    z = jnp.einsum('bqhd,bkhd->bhqk', q, k).astype(jnp.float32) * SB_SCALE
    mask = k_pos[None, :] < q_pos[:, None]
    log_1m = jnp.where(mask, jax.nn.log_sigmoid(-z), 0.0)
    tail = lax.cumsum(log_1m, axis=z.ndim - 1, reverse=True) - log_1m
    w = jnp.where(mask, jnp.exp(jax.nn.log_sigmoid(z) + tail), 0.0)
    return jnp.einsum('bhqk,bkhd->bqhd', w.astype(v.dtype), v)


def _blockwise(fn, q, q_pos):
    B, S = q.shape[:2]
    nb = S // Q_BLOCK
    qb = jnp.moveaxis(q.reshape((B, nb, Q_BLOCK) + q.shape[2:]), 1, 0)
    pb = q_pos.reshape(nb, Q_BLOCK)
    out = lax.map(lambda a: fn(a[0], a[1]), (qb, pb))
    return jnp.moveaxis(out, 0, 1).reshape((B, S) + out.shape[3:])


def _rel_index(dist):
    return jnp.clip(dist, -(CHUNK - 1), REL_MAX) + (CHUNK - 1)


def _mla_keys(ckv, kr, w_ukv):
    B, T = ckv.shape[:2]
    kv = (ckv @ w_ukv).reshape(B, T, H_A, NOPE_DIM + V_DIM)
    k = jnp.concatenate([kv[..., :NOPE_DIM], jnp.broadcast_to(kr[:, :, None, :], (B, T, H_A, ROPE_DIM))], -1)
    return k, kv[..., NOPE_DIM:]


def _even_project(x, pos, w_in, g_q, w_uq, g_kv):
    B, S, _ = x.shape
    h = x @ w_in
    o1 = Q_LORA
    o2 = o1 + KV_LORA
    o3 = o2 + ROPE_DIM
    q_a = (_rms_norm(h[..., :o1], g_q) @ w_uq).reshape(B, S, H_A, NOPE_DIM + ROPE_DIM)
    q_a = jnp.concatenate([q_a[..., :NOPE_DIM], _rope(q_a[..., NOPE_DIM:], pos)], -1)
    ckv = _rms_norm(h[..., o1:o2], g_kv)
    kr = _rope(h[..., o2:o3], pos)
    hb = h[..., o3:].reshape(B, S, 3, H_B, HEAD_DIM)
    return q_a, ckv, kr, hb[:, :, 0], hb[:, :, 1], hb[:, :, 2]


def _band_prompt(q, k, v, table):
    B, S, H, d = q.shape
    n_c = S // CHUNK
    n_band = PREV_CHUNKS + 1
    qc = q.reshape(B, n_c, CHUNK, H, d)
    pad = ((0, 0), (PREV_CHUNKS, 0), (0, 0), (0, 0), (0, 0))
    kc = jnp.pad(k.reshape(B, n_c, CHUNK, H, d), pad)
    vc = jnp.pad(v.reshape(B, n_c, CHUNK, H, d), pad)
    s = jnp.stack([jnp.einsum('bnihd,bnjhd->bhnij', qc, kc[:, PREV_CHUNKS - o:PREV_CHUNKS - o + n_c])
                   for o in range(n_band)], axis=-2).astype(jnp.float32) * BAND_SCALE
    off = jnp.arange(n_band)
    i = jnp.arange(CHUNK)
    dist = off[None, :, None] * CHUNK + i[:, None, None] - i[None, None, :]
    bias = table[:, _rel_index(dist)].astype(jnp.float32)
    valid = jnp.arange(n_c)[:, None] >= off[None, :]
    s = jnp.where(valid[None, None, :, None, :, None], s + bias[None, :, None], NEG_INF)
    p = jax.nn.softmax(s.reshape(B, H, n_c, CHUNK, n_band * CHUNK), axis=-1).reshape(s.shape).astype(v.dtype)
    out = sum(jnp.einsum('bhnij,bnjhd->bnihd', p[..., o, :], vc[:, PREV_CHUNKS - o:PREV_CHUNKS - o + n_c])
              for o in range(n_band))
    return out.reshape(B, S, H, d)


def _band_sample(q, k_all, v_all, n_past, table):
    T = q.shape[1]
    k_rel = jnp.arange(k_all.shape[1]) - n_past
    dist = jnp.arange(T)[:, None] - k_rel[None, :]
    bias = table[:, _rel_index(dist)].astype(jnp.float32)
    s = jnp.einsum('bqhd,bkhd->bhqk', q, k_all).astype(jnp.float32) * BAND_SCALE + bias[None]
    p = jax.nn.softmax(s, axis=-1)
    return jnp.einsum('bhqk,bkhd->bqhd', p.astype(v_all.dtype), v_all)


def _even_prompt(x, pos, w_in, g_q, w_uq, g_kv, w_ukv, table, w_out):
    B, S, _ = x.shape
    q_a, ckv, kr, q_b, k_b, v_b = _even_project(x, pos, w_in, g_q, w_uq, g_kv)
    k_a, v_a = _mla_keys(ckv, kr, w_ukv)
    o_a = _blockwise(lambda qb, pb: _softmax_attend(qb, k_a, v_a, _chunk_mask(pb, pos), MLA_SCALE), q_a, pos)
    o_b = _band_prompt(q_b, k_b, v_b, table)
    y = jnp.concatenate([o_a.reshape(B, S, H_A * V_DIM), o_b.reshape(B, S, H_B * HEAD_DIM)], -1) @ w_out
    rows = min(BAND_PAST, S)
    return y, ckv, kr, k_b[:, S - rows:], v_b[:, S - rows:]


def _even_sample(x, pos, c_ckv, c_kr, c_bk, c_bv, w_in, g_q, w_uq, g_kv, w_ukv, table, w_out):
    B, T, _ = x.shape
    q_a, ckv, kr, q_b, k_b, v_b = _even_project(x, pos, w_in, g_q, w_uq, g_kv)
    ckv_all = jnp.concatenate([c_ckv, ckv], 1)
    kr_all = jnp.concatenate([c_kr, kr], 1)
    k_a, v_a = _mla_keys(ckv_all, kr_all, w_ukv)
    o_a = _softmax_attend(q_a, k_a, v_a, _chunk_mask(pos, jnp.arange(ckv_all.shape[1])), MLA_SCALE)
    kb_all = jnp.concatenate([c_bk, k_b], 1)
    vb_all = jnp.concatenate([c_bv, v_b], 1)
    o_b = _band_sample(q_b, kb_all, vb_all, c_bk.shape[1], table)
    y = jnp.concatenate([o_a.reshape(B, T, H_A * V_DIM), o_b.reshape(B, T, H_B * HEAD_DIM)], -1) @ w_out
    rows = min(BAND_PAST, kb_all.shape[1])
    return y, ckv, kr, kb_all[:, kb_all.shape[1] - rows:], vb_all[:, vb_all.shape[1] - rows:]


def _odd_project(x, w_in):
    B, S, _ = x.shape
    h = (x @ w_in).reshape(B, S, 3, H_C, HEAD_DIM)
    return h[:, :, 0], h[:, :, 1], h[:, :, 2]


def _odd_prompt(x, pos, w_in, w_out):
    B, S, _ = x.shape
    q, k, v = _odd_project(x, w_in)
    o = _blockwise(lambda qb, pb: _stick_breaking(qb, k, v, pb, pos), q, pos)
    return o.reshape(B, S, MIX_C) @ w_out, k, v


def _odd_sample(x, pos, c_k, c_v, w_in, w_out):
    B, T, _ = x.shape
    q, k, v = _odd_project(x, w_in)
    k_all = jnp.concatenate([c_k, k], 1)
    v_all = jnp.concatenate([c_v, v], 1)
    o = _stick_breaking(q, k_all, v_all, pos, jnp.arange(k_all.shape[1]))
    return o.reshape(B, T, MIX_C) @ w_out, k, v


def _post_block(x, mix, g1, b1, g2, b2, w_up, w_down):
    x = _layer_norm(ALPHA * x + mix, g1, b1)
    ff = jnp.square(jax.nn.relu(x @ w_up)) @ w_down
    return _layer_norm(ALPHA * x + ff, g2, b2)


def setup_inputs(seed: int = 0) -> dict:
    key = jax.random.key(seed)
    ks = jax.random.split(key, 24)

    def nrm(k, shape, scale):
        return jax.random.normal(k, shape, jnp.float32) * scale

    band_rows = min(BAND_PAST, PAST_LEN)
    return {
        "x_prompt": nrm(ks[0], (BATCH, SEQ, D_MODEL), 1.0),
        "x_sample": nrm(ks[1], (DEC_BATCH, DEC_SEQ, D_MODEL), 1.0),
        "cache_mla_ckv": nrm(ks[2], (N_EVEN, DEC_BATCH, PAST_LEN, KV_LORA), 1.0),
        "cache_mla_krope": nrm(ks[3], (N_EVEN, DEC_BATCH, PAST_LEN, ROPE_DIM), 1.0),
        "cache_band_k": nrm(ks[4], (N_EVEN, DEC_BATCH, band_rows, H_B, HEAD_DIM), 1.0),
        "cache_band_v": nrm(ks[5], (N_EVEN, DEC_BATCH, band_rows, H_B, HEAD_DIM), 1.0),
        "cache_sb_k": nrm(ks[6], (N_ODD, DEC_BATCH, PAST_LEN, H_C, HEAD_DIM), 1.0),
        "cache_sb_v": nrm(ks[7], (N_ODD, DEC_BATCH, PAST_LEN, H_C, HEAD_DIM), 1.0),
        "w_in_ab": nrm(ks[8], (N_EVEN, D_MODEL, IN_AB), D_MODEL ** -0.5),
        "g_q_lat": 1.0 + nrm(ks[9], (N_EVEN, Q_LORA), 0.02),
        "w_uq": nrm(ks[10], (N_EVEN, Q_LORA, H_A * (NOPE_DIM + ROPE_DIM)), Q_LORA ** -0.5),
        "g_kv_lat": 1.0 + nrm(ks[11], (N_EVEN, KV_LORA), 0.02),
        "w_ukv": nrm(ks[12], (N_EVEN, KV_LORA, H_A * (NOPE_DIM + V_DIM)), KV_LORA ** -0.5),
        "rel_bias": nrm(ks[13], (N_EVEN, H_B, N_REL), 0.1),
        "w_out_ab": nrm(ks[14], (N_EVEN, MIX_AB, D_MODEL), BETA * MIX_AB ** -0.5),
        "w_in_c": nrm(ks[15], (N_ODD, D_MODEL, IN_C), D_MODEL ** -0.5),
        "w_out_c": nrm(ks[16], (N_ODD, MIX_C, D_MODEL), BETA * MIX_C ** -0.5),
        "ln_mix_g": 1.0 + nrm(ks[17], (DEPTH, D_MODEL), 0.02),
        "ln_mix_b": nrm(ks[18], (DEPTH, D_MODEL), 0.02),
        "ln_ffn_g": 1.0 + nrm(ks[19], (DEPTH, D_MODEL), 0.02),
        "ln_ffn_b": nrm(ks[20], (DEPTH, D_MODEL), 0.02),
        "w_ff_up": nrm(ks[21], (DEPTH, D_MODEL, D_FF), D_MODEL ** -0.5),
        "w_ff_down": nrm(ks[22], (DEPTH, D_FF, D_MODEL), BETA * D_FF ** -0.5),
    }


def reference(x_prompt, x_sample, cache_mla_ckv, cache_mla_krope, cache_band_k, cache_band_v,
              cache_sb_k, cache_sb_v, w_in_ab, g_q_lat, w_uq, g_kv_lat, w_ukv, rel_bias, w_out_ab,
              w_in_c, w_out_c, ln_mix_g, ln_mix_b, ln_ffn_g, ln_ffn_b, w_ff_up, w_ff_down):
    pos_p = jnp.arange(x_prompt.shape[1], dtype=jnp.int32)
    n_past = cache_mla_ckv.shape[2]
    pos_s = n_past + jnp.arange(x_sample.shape[1], dtype=jnp.int32)
    xp, xs = x_prompt, x_sample
    p_ckv, p_kr, p_bk, p_bv, p_sk, p_sv = [], [], [], [], [], []
    s_ckv, s_kr, s_bk, s_bv, s_sk, s_sv = [], [], [], [], [], []
    for l in range(DEPTH):
        i = l // 2
        if l % 2 == 0:
            mp, a1, a2, a3, a4 = _even_prompt(xp, pos_p, w_in_ab[i], g_q_lat[i], w_uq[i], g_kv_lat[i],
                                              w_ukv[i], rel_bias[i], w_out_ab[i])
            ms, b1, b2, b3, b4 = _even_sample(xs, pos_s, cache_mla_ckv[i], cache_mla_krope[i],
                                              cache_band_k[i], cache_band_v[i], w_in_ab[i], g_q_lat[i],
                                              w_uq[i], g_kv_lat[i], w_ukv[i], rel_bias[i], w_out_ab[i])
            p_ckv.append(a1); p_kr.append(a2); p_bk.append(a3); p_bv.append(a4)
            s_ckv.append(b1); s_kr.append(b2); s_bk.append(b3); s_bv.append(b4)
        else:
            mp, a1, a2 = _odd_prompt(xp, pos_p, w_in_c[i], w_out_c[i])
            ms, b1, b2 = _odd_sample(xs, pos_s, cache_sb_k[i], cache_sb_v[i], w_in_c[i], w_out_c[i])
            p_sk.append(a1); p_sv.append(a2)
            s_sk.append(b1); s_sv.append(b2)
        xp = _post_block(xp, mp, ln_mix_g[l], ln_mix_b[l], ln_ffn_g[l], ln_ffn_b[l], w_ff_up[l], w_ff_down[l])
        xs = _post_block(xs, ms, ln_mix_g[l], ln_mix_b[l], ln_ffn_g[l], ln_ffn_b[l], w_ff_up[l], w_ff_down[l])
    return (xp, xs,
            jnp.stack(p_ckv), jnp.stack(p_kr), jnp.stack(p_bk), jnp.stack(p_bv), jnp.stack(p_sk), jnp.stack(p_sv),
            jnp.stack(s_ckv), jnp.stack(s_kr), jnp.stack(s_bk), jnp.stack(s_bv), jnp.stack(s_sk), jnp.stack(s_sv))
```

```cpp
#include <hip/hip_runtime.h>
#include <hip/hip_bf16.h>
namespace pg8 {
#define PG8_LAS __attribute__((address_space(3)))
typedef unsigned short bf16_t;
typedef short bf16x8 __attribute__((ext_vector_type(8)));
typedef float f32x4 __attribute__((ext_vector_type(4)));
typedef unsigned u32x4 __attribute__((ext_vector_type(4)));
constexpr int BM = 256, BK = 64, HALF = 128, HTB = HALF * BK * 2  , STAGE_BYTES = 8 * HTB, NXCD = 8, WGM = 8;

__host__ __device__ __forceinline__ int lds_byte(int r, int c) { const int st = (r >> 4) * 2 + (c >> 5), rr = r & 15, cc = c & 31, ob = rr * 64 + cc * 2; return st * 1024 + (ob ^ (((ob >> 9) & 1) << 5)); }
__host__ __device__ __forceinline__ void stage_rc(int b, int& R, int& C) { const int st = b / 1024, sb = b % 1024, swz = sb ^ (((sb >> 9) & 1) << 5); R = (st >> 1) * 16 + swz / 64; C = (st & 1) * 32 + (swz % 64) / 2; }
__host__ __device__ __forceinline__ int perm32(int rho) { const int n = rho >> 4, i = rho & 15; return 8 * (i >> 2) + 4 * n + (i & 3); }

struct Unit { int pm, pn, ko; };
struct Gemm { const bf16_t* A; const bf16_t* Bt; int M, N, K, ld; };

struct StaticOrder {
    int nM, nN, nwg, G, c;
    __host__ __device__ void init(int M, int N, int G_, int c_) { nM = M / BM; nN = N / BM; nwg = nM * nN; G = G_; c = c_; }
    __host__ __device__ bool next(int i, Unit& u) const {
        const long L = (long)i * G + c; if (L >= nwg) return false;
        int wgid = (int)L; { const int q = nwg / NXCD, r = nwg % NXCD, xcd = wgid % NXCD, off = wgid / NXCD; wgid = (xcd < r ? xcd * (q + 1) : r * (q + 1) + (xcd - r) * q) + off; }
        const int nig = WGM * nN, gid = wgid / nig, fm = gid * WGM, gsz = (nM - fm) < WGM ? (nM - fm) : WGM;
        u.pm = fm + ((wgid % nig) % gsz); u.pn = (wgid % nig) / gsz; u.ko = 0; return true;
    }
    __device__ __forceinline__ void a_ready(const Unit&) const {}
    __device__ __forceinline__ void done(const Unit&) const {}
};
typedef float f32x2 __attribute__((ext_vector_type(2))); typedef __bf16 bf16x2v __attribute__((ext_vector_type(2)));
__device__ __forceinline__ unsigned cvt_pk_bf16(float lo, float hi) { f32x2 v = {lo, hi}; bf16x2v b = __builtin_convertvector(v, bf16x2v); return __builtin_bit_cast(unsigned, b); }
template <int ACT  > struct EpiBf16 {
    static constexpr bool PERM = true, AFTER_DRAIN = false;
    bf16_t* O; int ldc;
    __device__ __forceinline__ void operator()(const f32x4 (&acc)[2][2][4][2], const Unit& u, int wr, int wc, int fr, int fq) const {
        const int row0 = u.pm * BM + wr * 64 + fr; const int col0 = u.pn * BM + wc * 32 + 8 * fq;
#pragma unroll
        for (int ai = 0; ai < 2; ++ai)
#pragma unroll
            for (int m = 0; m < 4; ++m) { bf16_t* rowp = O + (size_t)(row0 + ai * HALF + m * 16) * ldc + col0;
#pragma unroll
                for (int bj = 0; bj < 2; ++bj) { f32x4 v0 = acc[ai][bj][m][0], v1 = acc[ai][bj][m][1];
                    if (ACT == 2) {
#pragma unroll
                        for (int e = 0; e < 4; ++e) { float a = fmaxf(v0[e], 0.f), b = fmaxf(v1[e], 0.f); v0[e] = a * a; v1[e] = b * b; } }
                    u32x4 w; w.x = cvt_pk_bf16(v0[0], v0[1]); w.y = cvt_pk_bf16(v0[2], v0[3]); w.z = cvt_pk_bf16(v1[0], v1[1]); w.w = cvt_pk_bf16(v1[2], v1[3]);
                    *(u32x4*)(rowp + bj * HALF) = w; } }
    }
};
struct EpiResF32 {
    static constexpr bool PERM = false, AFTER_DRAIN = false;
    const float* r0; const float* r1; int split; float* out; int ldc; float alpha;
    __device__ __forceinline__ void operator()(const f32x4 (&acc)[2][2][4][2], const Unit& u, int wr, int wc, int fr, int fq) const {
        const int col0 = u.pn * BM + wc * 32 + 4 * fq;
#pragma unroll
        for (int ai = 0; ai < 2; ++ai)
#pragma unroll
            for (int m = 0; m < 4; ++m) { const int row = u.pm * BM + ai * HALF + wr * 64 + m * 16 + fr;
                const float* rp = (row < split) ? r0 + (size_t)row * ldc : r1 + (size_t)(row - split) * ldc;
                float* op = out + (size_t)row * ldc;
#pragma unroll
                for (int bj = 0; bj < 2; ++bj)
#pragma unroll
                    for (int n = 0; n < 2; ++n) { const int c = col0 + bj * HALF + n * 16; const f32x4 rv = *(const f32x4*)(rp + c);
                        *(f32x4*)(op + c) = rv * alpha + acc[ai][bj][m][n]; } }
    }
};
template <size_t KP, size_t VP, size_t KS, size_t VS, int split, int ldc> struct EpiQKV {
    static constexpr bool PERM = true, AFTER_DRAIN = false;
    bf16_t* O; float* outp;
    __device__ __forceinline__ void operator()(const f32x4 (&acc)[2][2][4][2], const Unit& u, int wr, int wc, int fr, int fq) const {
        const int row0 = u.pm * BM + wr * 64 + fr; const int col0 = u.pn * BM + wc * 32 + 8 * fq;
        const int sel = u.pn >> 2;
        if (sel) {
            float* fbase = outp + (sel == 1 ? (u.pm * BM < split ? KP : KS) : (u.pm * BM < split ? VP : VS));
            fbase += (size_t)(row0 - (u.pm * BM < split ? 0 : split)) * 1024 + (col0 - sel * 1024);
#pragma unroll
            for (int ai = 0; ai < 2; ++ai)
#pragma unroll
                for (int m = 0; m < 4; ++m) { float* frow = fbase + (ai * HALF + m * 16) * 1024;
#pragma unroll
                    for (int bj = 0; bj < 2; ++bj) { *(f32x4*)(frow + bj * HALF) = acc[ai][bj][m][0]; *(f32x4*)(frow + bj * HALF + 4) = acc[ai][bj][m][1]; }
                    asm volatile("" ::: "memory"); }
        }
        bf16_t* obase = O + (size_t)row0 * ldc + col0;
#pragma unroll
        for (int ai = 0; ai < 2; ++ai)
#pragma unroll
            for (int m = 0; m < 4; ++m) { bf16_t* rowp = obase + (size_t)(ai * HALF + m * 16) * ldc;
#pragma unroll
                for (int bj = 0; bj < 2; ++bj) { const f32x4 v0 = acc[ai][bj][m][0], v1 = acc[ai][bj][m][1];
                    u32x4 w; w.x = cvt_pk_bf16(v0[0], v0[1]); w.y = cvt_pk_bf16(v0[2], v0[3]); w.z = cvt_pk_bf16(v1[0], v1[1]); w.w = cvt_pk_bf16(v1[2], v1[3]);
                    *(u32x4*)(rowp + bj * HALF) = w; }
                asm volatile("" ::: "memory"); }
    }
};
struct SplitOrder {
    int pm0, nN, S, Ksub, nunits, c, G;
    __device__ __forceinline__ bool next(int i, Unit& u) const { const int L = i * G + c; if (L >= nunits) return false; const int t = L / S, ks = L % S; u.pm = pm0 + t / nN; u.pn = t % nN; u.ko = ks * Ksub; return true; }
    __device__ __forceinline__ void a_ready(const Unit&) const {}
    __device__ __forceinline__ void done(const Unit&) const {}
};
struct EpiPart {
    static constexpr bool PERM = false, AFTER_DRAIN = false;
    float* part; int pm0, Ksub, rows, ldc;
    __device__ __forceinline__ void operator()(const f32x4 (&acc)[2][2][4][2], const Unit& u, int wr, int wc, int fr, int fq) const {
        const int col0 = u.pn * BM + wc * 32 + 4 * fq; float* base = part + ((size_t)(u.ko / Ksub) * rows + (size_t)(u.pm - pm0) * BM) * ldc;
#pragma unroll
        for (int ai = 0; ai < 2; ++ai)
#pragma unroll
            for (int m = 0; m < 4; ++m) { float* op = base + (size_t)(ai * HALF + wr * 64 + m * 16 + fr) * ldc;
#pragma unroll
                for (int bj = 0; bj < 2; ++bj)
#pragma unroll
                    for (int n = 0; n < 2; ++n) *(f32x4*)(op + col0 + bj * HALF + n * 16) = acc[ai][bj][m][n]; }
    }
};
template <bool RF32> struct EpiResH {
    static constexpr bool PERM = true, AFTER_DRAIN = false;
    const void* res; bf16_t* out; int ldc; float alpha;
    __device__ __forceinline__ void operator()(const f32x4 (&acc)[2][2][4][2], const Unit& u, int wr, int wc, int fr, int fq) const {
        const int row0 = u.pm * BM + wr * 64 + fr; const int col0 = u.pn * BM + wc * 32 + 8 * fq;
#pragma unroll
        for (int ai = 0; ai < 2; ++ai)
#pragma unroll
            for (int m = 0; m < 4; ++m) { const size_t off = (size_t)(row0 + ai * HALF + m * 16) * ldc + col0;
#pragma unroll
                for (int bj = 0; bj < 2; ++bj) { f32x4 r0, r1;
                    if (RF32) { r0 = *(const f32x4*)((const float*)res + off + bj * HALF); r1 = *(const f32x4*)((const float*)res + off + bj * HALF + 4); }
                    else { const u32x4 q = *(const u32x4*)((const bf16_t*)res + off + bj * HALF);
                        r0 = (f32x4){__builtin_bit_cast(float, q.x << 16), __builtin_bit_cast(float, q.x & 0xffff0000u), __builtin_bit_cast(float, q.y << 16), __builtin_bit_cast(float, q.y & 0xffff0000u)};
                        r1 = (f32x4){__builtin_bit_cast(float, q.z << 16), __builtin_bit_cast(float, q.z & 0xffff0000u), __builtin_bit_cast(float, q.w << 16), __builtin_bit_cast(float, q.w & 0xffff0000u)}; }
                    const f32x4 v0 = r0 * alpha + acc[ai][bj][m][0], v1 = r1 * alpha + acc[ai][bj][m][1];
                    u32x4 w; w.x = cvt_pk_bf16(v0[0], v0[1]); w.y = cvt_pk_bf16(v0[2], v0[3]); w.z = cvt_pk_bf16(v1[0], v1[1]); w.w = cvt_pk_bf16(v1[2], v1[3]);
                    *(u32x4*)(out + off + bj * HALF) = w; }
                if (m & 1) asm volatile("" ::: "memory"); }
    }
};
template <class Epi, class Sched, bool ALIGN_EPI = false, bool SP2 = false>
__device__ __forceinline__ void gemm_phase(PG8_LAS unsigned char* lds, const Gemm g, const Sched& S, const Epi& E) {
    const int tid = threadIdx.x, wid = __builtin_amdgcn_readfirstlane(tid >> 6), lane = tid & 63, wr = wid >> 2, wc = wid & 3, fr = lane & 15, fq = lane >> 4;
    const int K = g.K, LD = g.ld, nt = K / BK;
    unsigned voffA[2], voffB[2];
#pragma unroll
    for (int i = 0; i < 2; ++i) { int R, C; stage_rc(tid * 16 + i * 8192, R, C); const int Rb = Epi::PERM ? ((R & ~31) + perm32(R & 31)) : R;
        voffA[i] = (unsigned)(R * LD + C) * 2u; voffB[i] = (unsigned)(Rb * LD + C) * 2u; }
    const size_t kstep = (size_t)(BK * 2);
    const size_t hstep = (size_t)HALF * LD * 2;
    const size_t tstep = 2 * hstep;
    const unsigned ldsw = (unsigned)wid * 1024u;
    const int aoff = lds_byte(wr * 64 + fr, fq * 8), boff = lds_byte(wc * 32 + fr, fq * 8);
#define PG8_SA(b, h) (((b) * 2 + (h)) * HTB)
#define PG8_SB(b, h) ((4 + (b) * 2 + (h)) * HTB)
#define PG8_STAGE(bufoff, gbase, voff) do { _Pragma("unroll") for (int _i = 0; _i < 2; ++_i) \
        __builtin_amdgcn_global_load_lds((const unsigned*)((const char*)(gbase) + (voff)[_i]), (PG8_LAS unsigned*)(lds + (bufoff) + ldsw + _i * 8192), 16, 0, 0); } while (0)
#define PG8_LDA(dst, b, h) do { _Pragma("unroll") for (int m = 0; m < 4; ++m) _Pragma("unroll") for (int k = 0; k < 2; ++k) dst[m][k] = *(const PG8_LAS bf16x8*)(lds + PG8_SA(b, h) + aoff + m * 2048 + k * 1024); } while (0)
#define PG8_LDB(dst, b, h) do { _Pragma("unroll") for (int n = 0; n < 2; ++n) _Pragma("unroll") for (int k = 0; k < 2; ++k) dst[n][k] = *(const PG8_LAS bf16x8*)(lds + PG8_SB(b, h) + boff + n * 2048 + k * 1024); } while (0)
#define PG8_MMA(ai, bj, At, Bt) do { __builtin_amdgcn_s_setprio(1); _Pragma("unroll") for (int m = 0; m < 4; ++m) _Pragma("unroll") for (int n = 0; n < 2; ++n) _Pragma("unroll") for (int k = 0; k < 2; ++k) \
        acc[ai][bj][m][n] = __builtin_amdgcn_mfma_f32_16x16x32_bf16(Bt[n][k], At[m][k], acc[ai][bj][m][n], 0, 0, 0); __builtin_amdgcn_s_setprio(0); } while (0)
#define PG8_WAIT_V(n) asm volatile("s_waitcnt vmcnt(" #n ")" ::: "memory")
#define PG8_WAIT_L(n) asm volatile("s_waitcnt lgkmcnt(" #n ")" ::: "memory")
#define PG8_BAR __builtin_amdgcn_s_barrier()
#define PG8_SCHED __builtin_amdgcn_sched_barrier(0)
    Unit cur, nxt; int ui = 0;
    if (!S.next(0, cur)) return;
    f32x4 acc[2][2][4][2];
#pragma unroll
    for (int a = 0; a < 2; ++a)
#pragma unroll
        for (int b = 0; b < 2; ++b)
#pragma unroll
            for (int m = 0; m < 4; ++m)
#pragma unroll
                for (int n = 0; n < 2; ++n) acc[a][b][m][n] = (f32x4){0.f, 0.f, 0.f, 0.f};
    bf16x8 At[4][2], B0[2][2], B1[2][2];
    const char* cA = (const char*)g.A + (size_t)cur.pm * tstep + (size_t)cur.ko * 2; const char* cB = (const char*)g.Bt + (size_t)cur.pn * tstep + (size_t)cur.ko * 2;
    S.a_ready(cur);
    if constexpr (SP2) {
        PG8_STAGE(PG8_SB(0, 0), cB, voffB); PG8_STAGE(PG8_SB(0, 1), cB + hstep, voffB); PG8_STAGE(PG8_SA(0, 0), cA, voffA); PG8_STAGE(PG8_SA(0, 1), cA + hstep, voffA);
        if (wr == 1) PG8_BAR;
        PG8_WAIT_V(2); PG8_BAR;
        PG8_STAGE(PG8_SB(1, 0), cB + kstep, voffB); PG8_STAGE(PG8_SA(1, 0), cA + kstep, voffA); PG8_STAGE(PG8_SB(1, 1), cB + hstep + kstep, voffB);
        PG8_WAIT_V(6); PG8_BAR;
    } else {
        PG8_STAGE(PG8_SB(0, 0), cB, voffB); PG8_STAGE(PG8_SA(0, 0), cA, voffA); PG8_STAGE(PG8_SB(0, 1), cB + hstep, voffB); PG8_STAGE(PG8_SA(0, 1), cA + hstep, voffA);
        if (wr == 1) PG8_BAR;
        PG8_WAIT_V(4); PG8_BAR;
        PG8_STAGE(PG8_SB(1, 0), cB + kstep, voffB); PG8_STAGE(PG8_SA(1, 0), cA + kstep, voffA); PG8_STAGE(PG8_SB(1, 1), cB + hstep + kstep, voffB);
        PG8_WAIT_V(6); PG8_BAR;
    }
    for (;;) {
        const bool has_next = S.next(ui + 1, nxt);
        const char* nA = has_next ? (const char*)g.A + (size_t)nxt.pm * tstep + (size_t)nxt.ko * 2 : cA; const char* nB = has_next ? (const char*)g.Bt + (size_t)nxt.pn * tstep + (size_t)nxt.ko * 2 : cB;
        for (int t = 0; t < nt; t += 2) {
            const bool last = (t == nt - 2);
            const char* a1 = cA + (size_t)(t + 1) * kstep;
            const char* a2 = last ? nA : cA + (size_t)(t + 2) * kstep; const char* b2 = last ? nB : cB + (size_t)(t + 2) * kstep;
            const char* a3 = a2 + kstep; const char* b3 = b2 + kstep;
            if (last && has_next) S.a_ready(nxt);
            if constexpr (SP2) {
            PG8_LDB(B0, 0, 0); PG8_LDB(B1, 0, 1); PG8_SCHED; PG8_LDA(At, 0, 0); PG8_STAGE(PG8_SA(1, 1), a1 + hstep, voffA);
            PG8_WAIT_V(8); PG8_WAIT_L(0); PG8_BAR; PG8_MMA(0, 0, At, B0); PG8_MMA(0, 1, At, B1); PG8_BAR; PG8_SCHED;
            PG8_LDA(At, 0, 1); PG8_STAGE(PG8_SB(0, 0), b2, voffB); PG8_STAGE(PG8_SB(0, 1), b2 + hstep, voffB); PG8_STAGE(PG8_SA(0, 0), a2, voffA);
            PG8_WAIT_V(8); PG8_WAIT_L(0); PG8_BAR; PG8_MMA(1, 0, At, B0); PG8_MMA(1, 1, At, B1); PG8_BAR; PG8_SCHED;
            PG8_LDB(B0, 1, 0); PG8_LDB(B1, 1, 1); PG8_SCHED; PG8_LDA(At, 1, 0); PG8_STAGE(PG8_SA(0, 1), a2 + hstep, voffA);
            PG8_WAIT_V(8); PG8_WAIT_L(0); PG8_BAR; PG8_MMA(0, 0, At, B0); PG8_MMA(0, 1, At, B1); PG8_BAR; PG8_SCHED;
            PG8_LDA(At, 1, 1); PG8_STAGE(PG8_SB(1, 0), b3, voffB); PG8_STAGE(PG8_SB(1, 1), b3 + hstep, voffB); PG8_STAGE(PG8_SA(1, 0), a3, voffA);
            PG8_WAIT_V(8); PG8_WAIT_L(0); PG8_BAR; PG8_MMA(1, 0, At, B0); PG8_MMA(1, 1, At, B1); PG8_BAR; PG8_SCHED;
            } else {
            PG8_LDB(B0, 0, 0); PG8_SCHED; PG8_LDA(At, 0, 0); PG8_STAGE(PG8_SA(1, 1), a1 + hstep, voffA);
            PG8_WAIT_L(8); PG8_BAR; PG8_WAIT_L(0); PG8_MMA(0, 0, At, B0); PG8_BAR; PG8_SCHED;
            PG8_LDB(B1, 0, 1); PG8_STAGE(PG8_SB(0, 0), b2, voffB);
            PG8_BAR; PG8_WAIT_L(0); PG8_MMA(0, 1, At, B1); PG8_BAR;
            PG8_LDA(At, 0, 1); PG8_STAGE(PG8_SA(0, 0), a2, voffA);
            PG8_BAR; PG8_WAIT_L(0); PG8_MMA(1, 0, At, B0); PG8_BAR; PG8_SCHED;
            PG8_STAGE(PG8_SB(0, 1), b2 + hstep, voffB);
            PG8_WAIT_V(6); PG8_BAR; PG8_MMA(1, 1, At, B1); PG8_BAR;
            PG8_LDB(B0, 1, 0); PG8_SCHED; PG8_LDA(At, 1, 0); PG8_STAGE(PG8_SA(0, 1), a2 + hstep, voffA);
            PG8_WAIT_L(8); PG8_BAR; PG8_WAIT_L(0); PG8_MMA(0, 0, At, B0); PG8_BAR; PG8_SCHED;
            PG8_LDB(B1, 1, 1); PG8_STAGE(PG8_SB(1, 0), b3, voffB);
            PG8_BAR; PG8_WAIT_L(0); PG8_MMA(0, 1, At, B1); PG8_BAR;
            PG8_LDA(At, 1, 1); PG8_STAGE(PG8_SA(1, 0), a3, voffA);
            PG8_BAR; PG8_WAIT_L(0); PG8_MMA(1, 0, At, B0); PG8_BAR; PG8_SCHED;
            PG8_STAGE(PG8_SB(1, 1), b3 + hstep, voffB);
            PG8_WAIT_V(6); PG8_BAR; PG8_MMA(1, 1, At, B1); PG8_BAR;
            }
        }
        if constexpr (ALIGN_EPI) { if (wr == 0) PG8_BAR; }
        if constexpr (!Epi::AFTER_DRAIN) { E(acc, cur, wr, wc, fr, fq); S.done(cur); }
        if (!has_next) break;
#pragma unroll
        for (int a = 0; a < 2; ++a)
#pragma unroll
            for (int b = 0; b < 2; ++b)
#pragma unroll
                for (int m = 0; m < 4; ++m)
#pragma unroll
                    for (int n = 0; n < 2; ++n) acc[a][b][m][n] = (f32x4){0.f, 0.f, 0.f, 0.f};
        cur = nxt; cA = nA; cB = nB; ++ui;
        if constexpr (ALIGN_EPI) { if (wr == 1) PG8_BAR; }
    }
    PG8_WAIT_V(0);
    if constexpr (!ALIGN_EPI) { if (wr == 0) PG8_BAR; }
    PG8_BAR;
    if constexpr (Epi::AFTER_DRAIN) { E.fused(acc, cur, wr, wc, fr, fq, lds, wid, lane); S.done(cur); }
#undef PG8_SA
#undef PG8_SB
#undef PG8_STAGE
#undef PG8_LDA
#undef PG8_LDB
#undef PG8_MMA
#undef PG8_WAIT_V
#undef PG8_WAIT_L
#undef PG8_BAR
#undef PG8_SCHED
}
}

#include <hip/hip_cooperative_groups.h>
#include <cstdio>
#include <cstdint>
namespace cg = cooperative_groups;
#define GAS __attribute__((address_space(1)))
#define LAS __attribute__((address_space(3)))
typedef unsigned short bf16;
typedef unsigned v4u __attribute__((ext_vector_type(4)));
typedef unsigned v2u __attribute__((ext_vector_type(2)));
typedef float f32x4 __attribute__((ext_vector_type(4)));
typedef float f32x16 __attribute__((ext_vector_type(16)));
typedef short bf16x8 __attribute__((ext_vector_type(8)));
typedef short v4i16_t __attribute__((ext_vector_type(4)));
#define LDS_WAIT() asm volatile("s_waitcnt lgkmcnt(0)" ::: "memory")
__device__ __forceinline__ unsigned f2bf(float f) { unsigned u = __builtin_bit_cast(unsigned, f); return (u + 0x7fffu + ((u >> 16) & 1u)) >> 16; }
typedef float f32x2_t __attribute__((ext_vector_type(2))); typedef __bf16 bf16x2_t __attribute__((ext_vector_type(2)));
__device__ __forceinline__ unsigned pk2(float lo, float hi) { f32x2_t v = {lo, hi}; bf16x2_t b = __builtin_convertvector(v, bf16x2_t); return __builtin_bit_cast(unsigned, b); }
__device__ __forceinline__ float bflo(unsigned w) { return __builtin_bit_cast(float, w << 16); }
__device__ __forceinline__ float bfhi(unsigned w) { return __builtin_bit_cast(float, w & 0xffff0000u); }
__device__ __forceinline__ float bf1(unsigned short s) { return __builtin_bit_cast(float, (unsigned)s << 16); }

constexpr int DM = 1024, SEQ = 4096, NB = 8, DB = 32, DS = 64, PAST = 1024;
constexpr int MP = NB * SEQ, MS = DB * DS, M = MP + MS;
constexpr int IN_AB = 2592, IN_ABP = 2816, IN_C = 3072, FF = 4096, QL = 768, KVL = 256;
constexpr int MKV = M + DB * PAST;
constexpr float ALPHA = 1.4142135623730951f;
constexpr float LOG2E = 1.4426950408889634f;

constexpr size_t O_Y = 0, O_CKVP = 35651584, O_KRP = 44040192, O_BKP = 45088768, O_BVP = 47185920, O_SKP = 49283072, O_SVP = 82837504,
                 O_CKVS = 116391936, O_KRS = 116916224, O_BKS = 116981760, O_BVS = 125370368, O_SKS = 133758976, O_SVS = 135856128, O_END = 137953280;
constexpr size_t W_INAB = 1u << 20, W_UQ = W_INAB + (size_t)IN_ABP * DM * 2, W_UKV = W_UQ + (size_t)768 * 768 * 2, W_OUTAB = W_UKV + (size_t)1024 * 256 * 2,
                 W_INC = W_OUTAB + (size_t)DM * DM * 2, W_OUTC = W_INC + (size_t)IN_C * DM * 2, W_UP = W_OUTC + (size_t)DM * DM * 2, W_DOWN = W_UP + (size_t)2 * FF * DM * 2,
                 W_ROPE = W_DOWN + (size_t)2 * FF * DM * 2, W_XB = W_ROPE + (size_t)SEQ * 32 * 4, W_H = W_XB + (size_t)M * DM * 2, W_KV = W_H + (size_t)M * IN_C * 2,
                 W_END = W_KV + (size_t)MKV * 1024 * 2;
constexpr size_t W_PART = W_END, W_XH = W_PART + (size_t)8 * MS * DM * 4, W_END2 = W_XH + (size_t)M * DM * 2;
static_assert((size_t)M * FF * 2 <= W_END - W_H, "U overlay");
static_assert((size_t)2 * DB * PAST * 1024 * 2 <= W_END - W_KV, "csb overlay");
constexpr size_t S_QL = O_SKP * 4, S_QA = S_QL + (size_t)M * 768 * 2;
constexpr size_t S_CKV = O_SVP * 4, S_KR = S_CKV + (size_t)MKV * 256 * 2, S_CBK = S_KR + (size_t)MKV * 32 * 2, S_CBV = S_CBK + (size_t)DB * 512 * 512 * 2, S_END2 = S_CBV + (size_t)DB * 512 * 512 * 2;
static_assert(S_QA + (size_t)M * 768 * 2 <= O_SVP * 4 && S_END2 <= O_CKVS * 4, "d_out scratch");

constexpr int LDS_BYTES = 147456;

struct Args {
    const float* in[23]; float* out; unsigned char* ws; int ph_lo, ph_hi;
};

#define dpp_add(v, old, ctrl, rmask) __builtin_bit_cast(float, __builtin_amdgcn_update_dpp(__builtin_bit_cast(int, (float)(old)), __builtin_bit_cast(int, (float)(v)), (ctrl), (rmask), 0xF, false))
__device__ __forceinline__ float wave_sum(float v) {
    v += dpp_add(v, 0.f, 0xB1, 0xF);
    v += dpp_add(v, 0.f, 0x4E, 0xF);
    v += dpp_add(v, 0.f, 0x141, 0xF);
    v += dpp_add(v, 0.f, 0x140, 0xF);
    v += dpp_add(v, 0.f, 0x142, 0xA);
    v += dpp_add(v, 0.f, 0x143, 0xC);
    return __builtin_bit_cast(float, __builtin_amdgcn_readlane(__builtin_bit_cast(int, v), 63));
}
__device__ __forceinline__ void transpose_item(const float* W, int K, int N, bf16* WT, LAS float* scr, int item, int lane, float sc0 = 1.f, int nlim = 1 << 30) {
    const int nblk = N / 32, kb = item / nblk, nb = item % nblk, k0 = 64 * kb, n0 = 32 * nb; const float sc = n0 < nlim ? sc0 : 1.f;
#pragma unroll 8
    for (int i = 0; i < 32; ++i) { const int kk = 2 * i + (lane >> 5); scr[kk * 33 + (lane & 31)] = W[(size_t)(k0 + kk) * N + n0 + (lane & 31)] * sc; }
    LDS_WAIT(); asm volatile("" ::: "memory");
    const int c = lane & 7;
#pragma unroll
    for (int j = 0; j < 4; ++j) { const int n = (lane >> 3) + 8 * j; const LAS float* s = scr + (8 * c) * 33 + n;
        v4u o; o.x = pk2(s[0 * 33], s[1 * 33]); o.y = pk2(s[2 * 33], s[3 * 33]); o.z = pk2(s[4 * 33], s[5 * 33]); o.w = pk2(s[6 * 33], s[7 * 33]);
        *(v4u*)(WT + (size_t)(n0 + n) * K + k0 + 8 * c) = o; }
    LDS_WAIT(); asm volatile("" ::: "memory");
}
__device__ __forceinline__ void cvt_rows(const float* src, bf16* dst, size_t n8, size_t gt, size_t gn) {
    for (size_t i = gt; i < n8; i += gn) { const f32x4 a = *(const f32x4*)(src + i * 8), b = *(const f32x4*)(src + i * 8 + 4);
        v4u o; o.x = pk2(a[0], a[1]); o.y = pk2(a[2], a[3]); o.z = pk2(b[0], b[1]); o.w = pk2(b[2], b[3]); *(v4u*)(dst + i * 8) = o; }
}

namespace att {
constexpr int VSTR = 192, KB_MAX = 64 * 208, VB = 64 * VSTR, BUFSZ = KB_MAX + VB, BIAS_OFF = 2 * BUFSZ;
struct AU {
    const bf16* q; int qp;
    const bf16 *kA, *vA, *rA; int pA;
    const bf16 *kB, *vB, *rB; int pB;
    const float *kAf, *vAf;
    bf16* o; int op;
    int ntA, nrows, qpos0, h;
};
__device__ __forceinline__ float halves_max(float m) { auto rr = __builtin_amdgcn_permlane32_swap(__float_as_uint(m), __float_as_uint(m), false, false); return fmaxf(__uint_as_float(rr[0]), __uint_as_float(rr[1])); }
__device__ __forceinline__ float halves_sum(float m) { auto rr = __builtin_amdgcn_permlane32_swap(__float_as_uint(m), __float_as_uint(m), false, false); return __uint_as_float(rr[0]) + __uint_as_float(rr[1]); }
__device__ __forceinline__ float partner(float m, int hi) { auto rr = __builtin_amdgcn_permlane32_swap(__float_as_uint(m), __float_as_uint(m), false, false); return hi ? __uint_as_float(rr[0]) : __uint_as_float(rr[1]); }
__device__ __forceinline__ int crow(int r, int hi) { return (r & 3) + 8 * (r >> 2) + 4 * hi; }
#define MFMA32(a, b, c) __builtin_amdgcn_mfma_f32_32x32x16_bf16((a), (b), (c), 0, 0, 0)

struct TL { unsigned long long a[3], b[3]; int sa[3], sb[3], ld[3], c[3]; };
template <int MODE> __device__ __forceinline__ void tile_ctx(const AU& U, int tid, TL& C) {
    constexpr int CPR = MODE == 0 ? 20 : 16, NCH = 64 * CPR, NLD = (NCH + 511) / 512, KC = MODE == 0 ? 12 : 8, KSTR = MODE == 0 ? 208 : 144;
#pragma unroll
    for (int i = 0; i < NLD; ++i) { const int c0 = tid + 512 * i; const int c = c0 < NCH ? c0 : c0 - 512;
        const int row = c / CPR, cc = c % CPR; C.c[i] = c;
        const bool isk = cc < 8, isr = (MODE == 0) && cc >= 8 && cc < 12; const int vo = cc - (MODE == 0 ? 12 : 8);
        const unsigned long long kAa = (unsigned long long)U.kA, vAa = (unsigned long long)U.vA, rAa = (unsigned long long)U.rA, kBa = (unsigned long long)U.kB, vBa = (unsigned long long)U.vB, rBa = (unsigned long long)U.rB;
        const unsigned long long offA = isr ? (unsigned long long)(row * 32 + (cc - 8) * 8) * 2ull : ((unsigned long long)row * (unsigned long long)U.pA + (unsigned long long)((isk ? cc : vo) * 8)) * 2ull;
        const unsigned long long offB = isr ? (unsigned long long)(row * 32 + (cc - 8) * 8) * 2ull : ((unsigned long long)row * (unsigned long long)U.pB + (unsigned long long)((isk ? cc : vo) * 8)) * 2ull;
        C.a[i] = (isk ? kAa : (isr ? rAa : vAa)) + offA; C.b[i] = (isk ? kBa : (isr ? rBa : vBa)) + offB;
        C.sa[i] = (isr ? 64 * 32 : 64 * U.pA) * 2; C.sb[i] = (isr ? 64 * 32 : 64 * U.pB) * 2;
        C.ld[i] = cc < KC ? row * KSTR + cc * 16 : KB_MAX + row * VSTR + (cc - KC) * 16; }
}
template <int MODE> __device__ __forceinline__ void tile_loads(const AU& U, const TL& C, int T, v4u (&pre)[3]) {
    constexpr int CPR = MODE == 0 ? 20 : 16, NCH = 64 * CPR, NLD = (NCH + 511) / 512;
    const bool useA = T < U.ntA;
    if (MODE != 0 && useA && U.kAf) {
#pragma unroll
        for (int i = 0; i < NLD; ++i) { const int row = C.c[i] / CPR, cc = C.c[i] % CPR;
            const float* fs = cc < 8 ? U.kAf + (size_t)(T * 64 + row) * U.pA + cc * 8 : U.vAf + (size_t)(T * 64 + row) * U.pA + (cc - 8) * 8;
            const f32x4 a = *(const f32x4*)fs, b = *(const f32x4*)(fs + 4); v4u o; o.x = pk2(a[0], a[1]); o.y = pk2(a[2], a[3]); o.z = pk2(b[0], b[1]); o.w = pk2(b[2], b[3]); pre[i] = o; }
    } else {
        const int tt = useA ? T : T - U.ntA;
#pragma unroll
        for (int i = 0; i < NLD; ++i) { const unsigned long long src = useA ? C.a[i] + (unsigned long long)tt * (unsigned long long)C.sa[i] : C.b[i] + (unsigned long long)tt * (unsigned long long)C.sb[i]; pre[i] = *(const GAS v4u*)src; }
    }
}
template <int MODE> __device__ __forceinline__ void tile_stores(LAS unsigned char* buf, const TL& C, const v4u (&pre)[3]) {
    constexpr int NLD = ((MODE == 0 ? 20 : 16) * 64 + 511) / 512;
#pragma unroll
    for (int i = 0; i < NLD; ++i) *(LAS v4u*)(buf + C.ld[i]) = pre[i];
}

template <int MODE> __device__ __forceinline__ void st_qk(const LAS unsigned char* buf, int r, int hi, const bf16x8 (&qf)[MODE == 0 ? 6 : 4], const f32x16& negm, f32x16& s0, f32x16& s1) {
    constexpr int NS = MODE == 0 ? 6 : 4, KSTR = MODE == 0 ? 208 : 144;
    const LAS unsigned char* kb = buf + r * KSTR + hi * 16;
#pragma unroll
    for (int s = 0; s < NS; ++s) { const bf16x8 a0 = *(const LAS bf16x8*)(kb + 32 * s), a1 = *(const LAS bf16x8*)(kb + 32 * KSTR + 32 * s);
        if (s == 0) { s0 = MFMA32(a0, qf[0], negm); s1 = MFMA32(a1, qf[0], negm); }
        else { s0 = MFMA32(a0, qf[s], s0); s1 = MFMA32(a1, qf[s], s1); } }
}
template <int MODE> __device__ __forceinline__ void st_sm(int T, int tq, int qpos, int hi, const LAS float* biasl, f32x16& s0, f32x16& s1, f32x16& o0, f32x16& o1, f32x16& negm, float& lrun, bool& fresh) {
    const float c2 = 0.125f * LOG2E;
    if (MODE == 1) {
        if (T + 5 <= tq) { const float cb = biasl[0];
#pragma unroll
            for (int i = 0; i < 16; ++i) { s0[i] = s0[i] * c2 + cb; s1[i] = s1[i] * c2 + cb; } }
        else if (T + 3 >= tq) { const volatile LAS float* bp = biasl + (256 - qpos + T * 64 + 4 * hi);
#pragma unroll
            for (int i = 0; i < 16; ++i) { s0[i] = s0[i] * c2 + bp[(i & 3) + 8 * (i >> 2)]; s1[i] = s1[i] * c2 + bp[(i & 3) + 8 * (i >> 2) + 32]; } }
        else {
#pragma unroll
            for (int i = 0; i < 16; ++i) { const int d0 = qpos - (T * 64 + crow(i, hi)); const int i0 = 256 - min(max(d0, -63), 256), i1 = 256 - min(max(d0 - 32, -63), 256);
                s0[i] = s0[i] * c2 + biasl[i0]; s1[i] = s1[i] * c2 + biasl[i1]; } }
    }
#define MX3_(a, b, c) __builtin_fmaxf(__builtin_fmaxf((a), (b)), (c))
    float ma = MX3_(s0[0], s0[1], s1[0]), mb = MX3_(s0[2], s0[3], s1[1]); ma = MX3_(ma, s1[2], s1[3]);
#pragma unroll
    for (int i = 4; i < 16; i += 4) { ma = MX3_(ma, s0[i], s0[i + 1]); mb = MX3_(mb, s0[i + 2], s0[i + 3]); ma = MX3_(ma, s1[i], s1[i + 1]); mb = MX3_(mb, s1[i + 2], s1[i + 3]); }
#undef MX3_
    float mx = halves_max(__builtin_fmaxf(ma, mb));
    if (fresh || __any(mx > 6.0f)) {
        const float dl = fresh ? mx : fmaxf(mx, 0.f), al = __builtin_amdgcn_exp2f(-dl); lrun *= al; fresh = false;
        const float dn = (MODE == 0) ? dl : dl * (8.0f / LOG2E);
#pragma unroll
        for (int i = 0; i < 16; ++i) { s0[i] -= dl; s1[i] -= dl; o0[i] *= al; o1[i] *= al; negm[i] -= dn; } }
    float sum = 0.f;
#pragma unroll
    for (int i = 0; i < 16; ++i) { s0[i] = __builtin_amdgcn_exp2f(s0[i]); s1[i] = __builtin_amdgcn_exp2f(s1[i]); sum += s0[i] + s1[i]; }
    lrun += sum;
}
__device__ __forceinline__ void st_vread(const LAS unsigned char* buf, int vlane, bf16x8 (&vf)[8]) {
    const LAS unsigned char* vb = buf + KB_MAX + vlane;
#pragma unroll
    for (int ks = 0; ks < 4; ++ks) {
#pragma unroll
        for (int db = 0; db < 2; ++db) {
            const v4i16_t lo = __builtin_amdgcn_ds_read_tr16_b64_v4i16((LAS v4i16_t*)(vb + (16 * ks) * VSTR + db * 64));
            const v4i16_t hh = __builtin_amdgcn_ds_read_tr16_b64_v4i16((LAS v4i16_t*)(vb + (16 * ks + 8) * VSTR + db * 64));
            vf[2 * ks + db] = (bf16x8){lo[0], lo[1], lo[2], lo[3], hh[0], hh[1], hh[2], hh[3]}; } }
}
__device__ __forceinline__ void st_pv(const bf16x8 (&vf)[8], const f32x16& s0, const f32x16& s1, f32x16& o0, f32x16& o1) {
    bf16x8 pf[4];
#pragma unroll
    for (int s = 0; s < 2; ++s) {
        v4u a, b;
        a.x = pk2(s0[8 * s], s0[8 * s + 1]); a.y = pk2(s0[8 * s + 2], s0[8 * s + 3]); a.z = pk2(s0[8 * s + 4], s0[8 * s + 5]); a.w = pk2(s0[8 * s + 6], s0[8 * s + 7]);
        b.x = pk2(s1[8 * s], s1[8 * s + 1]); b.y = pk2(s1[8 * s + 2], s1[8 * s + 3]); b.z = pk2(s1[8 * s + 4], s1[8 * s + 5]); b.w = pk2(s1[8 * s + 6], s1[8 * s + 7]);
        pf[s] = __builtin_bit_cast(bf16x8, a); pf[2 + s] = __builtin_bit_cast(bf16x8, b); }
#pragma unroll
    for (int ks = 0; ks < 4; ++ks) { o0 = MFMA32(vf[2 * ks], pf[ks], o0); o1 = MFMA32(vf[2 * ks + 1], pf[ks], o1); }
}
template <int MODE> __device__ __forceinline__ void attn_unit(const AU& U, LAS unsigned char* lds, const float* rope, const float* biasg) {
    constexpr int NS = MODE == 0 ? 6 : 4;
    int tid = threadIdx.x; asm volatile("" : "+v"(tid));
    const int lane = tid & 63, r = lane & 31, hi = lane >> 5, w = __builtin_amdgcn_readfirstlane(tid >> 6);
    const bool active = 32 * w < U.nrows;
    const int tq = (U.qpos0 + 32 * w) >> 6;
    const int wlo = MODE == 1 ? (tq > 8 ? tq - 8 : 0) : 0, whi = tq;
    const int g0 = U.qpos0 >> 6;
    const int glo = MODE == 1 ? (g0 > 8 ? g0 - 8 : 0) : 0, ghi = (U.qpos0 + U.nrows - 1) >> 6;
    const int qpos = U.qpos0 + 32 * w + r;
    LAS float* biasl = (LAS float*)(lds + BIAS_OFF);
    if (MODE == 1) { for (int i = tid; i < 320; i += 512) biasl[i] = biasg[U.h * 320 + 319 - i] * LOG2E; }
    bf16x8 qf[NS];
    if (active) { const bf16* qrow = U.q + (size_t)(32 * w + r) * U.qp;
#pragma unroll
        for (int s = 0; s < NS; ++s) qf[s] = *(const bf16x8*)(qrow + 16 * s + 8 * hi);
        if (MODE == 0) { const float* rp = rope + (size_t)qpos * 32 + 16 * hi;
#pragma unroll
            for (int j = 0; j < 8; ++j) { const float cs = rp[2 * j], sn = rp[2 * j + 1]; const float x1 = bf1((unsigned short)qf[4][j]), x2 = bf1((unsigned short)qf[5][j]);
                qf[4][j] = (short)f2bf(x1 * cs - x2 * sn); qf[5][j] = (short)f2bf(x2 * cs + x1 * sn); } }
    } else {
#pragma unroll
        for (int s = 0; s < NS; ++s) qf[s] = (bf16x8){0, 0, 0, 0, 0, 0, 0, 0};
    }
    f32x16 o0, o1;
#pragma unroll
    for (int i = 0; i < 16; ++i) { o0[i] = 0.f; o1[i] = 0.f; }
    float lrun = 0.f; bool fresh = true; f32x16 negm;
#pragma unroll
    for (int i = 0; i < 16; ++i) negm[i] = 0.f;
    v4u preA[3], preB[3]; TL C; tile_ctx<MODE>(U, tid, C);
    tile_loads<MODE>(U, C, glo, preA); tile_stores<MODE>(lds, C, preA);
    tile_loads<MODE>(U, C, (glo < ghi ? glo + 1 : ghi), preA);
    __syncthreads();
    int cur = 0;
    const int vlane = (4 * hi + ((lane & 15) >> 2)) * VSTR + ((lane >> 4) & 1) * 32 + (lane & 3) * 8;
#define ATT_ITER(PX, PY) { \
        const bool has_next = T < ghi; \
        tile_loads<MODE>(U, C, (T + 2 < ghi ? T + 2 : ghi), PY);     \
        const LAS unsigned char* buf = lds + cur * BUFSZ; \
        if (active && T >= wlo && T <= whi) { f32x16 s0, s1; bf16x8 vf[8]; st_qk<MODE>(buf, r, hi, qf, negm, s0, s1); st_vread(buf, vlane, vf); st_sm<MODE>(T, tq, qpos, hi, biasl, s0, s1, o0, o1, negm, lrun, fresh); st_pv(vf, s0, s1, o0, o1); } \
        if (has_next) tile_stores<MODE>(lds + (cur ^ 1) * BUFSZ, C, PX); \
        asm volatile("s_waitcnt lgkmcnt(0)" ::: "memory"); __builtin_amdgcn_s_barrier(); asm volatile("" ::: "memory"); \
        if (!has_next) break; \
        cur ^= 1; ++T; }
    for (int T = glo;;) { ATT_ITER(preA, preB); ATT_ITER(preB, preA); }
#undef ATT_ITER
    if (active) {
        const float inv = 1.f / halves_sum(lrun);
        bf16* orow = U.o + (size_t)(32 * w + r) * U.op + 4 * hi;
#pragma unroll
        for (int g = 0; g < 4; ++g) {
            v2u a, b; a.x = pk2(o0[4 * g] * inv, o0[4 * g + 1] * inv); a.y = pk2(o0[4 * g + 2] * inv, o0[4 * g + 3] * inv);
            b.x = pk2(o1[4 * g] * inv, o1[4 * g + 1] * inv); b.y = pk2(o1[4 * g + 2] * inv, o1[4 * g + 3] * inv);
            *(v2u*)(orow + 8 * g) = a; *(v2u*)(orow + 32 + 8 * g) = b; }
    }
    __syncthreads();
}
}


constexpr int SB_HB = 2 * 64 * 144;
template <bool SMP> __device__ __forceinline__ void sb_loads(const bf16* Hb, const float* c_sk, const float* c_sv, int b, int c, int hg, int T, int tid, v4u (&pre)[8]) {
    const bool f32src = SMP && T < 16;
    if (!f32src) { const size_t srow0 = SMP ? (size_t)MP + b * 64 : (size_t)b * SEQ + (size_t)T * 64;
#pragma unroll
        for (int i = 0; i < 8; ++i) { const int ch = tid + 512 * i, row = ch >> 6, cc = ch & 63;
            pre[i] = *(const v4u*)(Hb + (srow0 + row) * IN_C + (cc >= 32 ? 2048 : 1024) + hg * 256 + (cc & 31) * 8); } }
    else {
#pragma unroll
        for (int hf = 0; hf < 2; ++hf) {
#pragma unroll
            for (int i2 = 0; i2 < 4; ++i2) { const int i = hf * 4 + i2; const int ch = tid + 512 * i, row = ch >> 6, cc = ch & 63;
                const float* fs = (cc >= 32 ? c_sv : c_sk) + ((size_t)b * PAST + (size_t)T * 64 + row) * 1024 + hg * 256 + (cc & 31) * 8;
                const f32x4 a = *(const f32x4*)fs, bq = *(const f32x4*)(fs + 4); v4u o; o.x = pk2(a[0], a[1]); o.y = pk2(a[2], a[3]); o.z = pk2(bq[0], bq[1]); o.w = pk2(bq[2], bq[3]); pre[i] = o; }
            asm volatile("" ::: "memory"); } }
}
__device__ __forceinline__ void sb_stores(LAS unsigned char* lds, int tid, const v4u (&pre)[8]) {
#pragma unroll
    for (int i = 0; i < 8; ++i) { const int ch = tid + 512 * i, row = ch >> 6, cc = ch & 63;
        *(LAS v4u*)(lds + ((cc & 31) >> 3) * SB_HB + (cc >= 32 ? 9216 : 0) + row * 144 + (cc & 7) * 16) = pre[i]; }
}
template <bool SMP> __device__ __forceinline__ void sb_unit4(const bf16* Hb, const float* c_sk, const float* c_sv, bf16* O, int b, int c, int hg, LAS unsigned char* lds) {
    using namespace att;
    int tid = threadIdx.x; asm volatile("" : "+v"(tid));
    const int lane = tid & 63, r = lane & 31, hi = lane >> 5, w = __builtin_amdgcn_readfirstlane(tid >> 6), hw = w >> 1, half = w & 1;
    const int tq = SMP ? 16 : c;
    const size_t qrow = (SMP ? (size_t)MP + b * 64 : (size_t)b * SEQ + (size_t)c * 64) + 32 * half + r;
    const int qpos = tq * 64 + 32 * half + r;
    bf16x8 qf[4];
#pragma unroll
    for (int s = 0; s < 4; ++s) qf[s] = *(const bf16x8*)(Hb + qrow * IN_C + (hg * 4 + hw) * 64 + 16 * s + 8 * hi);
    f32x16 o0, o1;
#pragma unroll
    for (int i = 0; i < 16; ++i) { o0[i] = 0.f; o1[i] = 0.f; }
    float carry = 1.f;
    v4u pre[8];
    sb_loads<SMP>(Hb, c_sk, c_sv, b, c, hg, tq, tid, pre);
    LAS unsigned char* hb = lds + hw * SB_HB;
    const int vlane = (4 * hi + ((lane & 15) >> 2)) * 144 + ((lane >> 4) & 1) * 32 + (lane & 3) * 8;
    for (int T = tq;; --T) {
        sb_stores(lds, tid, pre);
        __syncthreads();
        const bool has_next = T > 0;
        if (has_next) sb_loads<SMP>(Hb, c_sk, c_sv, b, c, hg, T - 1, tid, pre);
        {
            const LAS unsigned char* kb = hb + r * 144 + hi * 16;
            f32x16 s0, s1; const f32x16 zero16 = {0.f, 0.f, 0.f, 0.f, 0.f, 0.f, 0.f, 0.f, 0.f, 0.f, 0.f, 0.f, 0.f, 0.f, 0.f, 0.f};
#pragma unroll
            for (int s = 0; s < 4; ++s) { const bf16x8 a0 = *(const LAS bf16x8*)(kb + 32 * s), a1 = *(const LAS bf16x8*)(kb + 32 * 144 + 32 * s);
                if (s == 0) { s0 = MFMA32(a0, qf[0], zero16); s1 = MFMA32(a1, qf[0], zero16); } else { s0 = MFMA32(a0, qf[s], s0); s1 = MFMA32(a1, qf[s], s1); } }
            bf16x8 vf[8];
            { const LAS unsigned char* vb = hb + 9216 + vlane;
#pragma unroll
              for (int ks = 0; ks < 4; ++ks) {
#pragma unroll
                for (int db = 0; db < 2; ++db) {
                    const v4i16_t lo = __builtin_amdgcn_ds_read_tr16_b64_v4i16((LAS v4i16_t*)(vb + (16 * ks) * 144 + db * 64));
                    const v4i16_t hh = __builtin_amdgcn_ds_read_tr16_b64_v4i16((LAS v4i16_t*)(vb + (16 * ks + 8) * 144 + db * 64));
                    vf[2 * ks + db] = (bf16x8){lo[0], lo[1], lo[2], lo[3], hh[0], hh[1], hh[2], hh[3]}; } } }
            f32x16 U0, U1;
#pragma unroll
            for (int i = 0; i < 16; ++i) {
                const float e0 = __builtin_amdgcn_exp2f(s0[i]), e1 = __builtin_amdgcn_exp2f(s1[i]);
                U0[i] = __builtin_amdgcn_rcpf(1.f + e0); U1[i] = __builtin_amdgcn_rcpf(1.f + e1);
                s0[i] = 1.f - U0[i]; s1[i] = 1.f - U1[i]; }
            if (T == tq) {
#pragma unroll
                for (int i = 0; i < 16; ++i) { const int kv = T * 64 + crow(i, hi);
                    if (kv >= qpos) { U0[i] = 1.f; s0[i] = 0.f; } if (kv + 32 >= qpos) { U1[i] = 1.f; s1[i] = 0.f; } } }
            float R = carry;
#pragma unroll
            for (int bg = 7; bg >= 0; --bg) { const int g = bg & 3;
                if (bg >= 4) { const float gs = (U1[4 * g] * U1[4 * g + 1]) * (U1[4 * g + 2] * U1[4 * g + 3]); const float gp = partner(gs, hi);
                    const float t3 = hi ? R : R * gp, t2 = t3 * U1[4 * g + 3], t1 = t2 * U1[4 * g + 2], t0 = t1 * U1[4 * g + 1];
                    s1[4 * g + 3] *= t3; s1[4 * g + 2] *= t2; s1[4 * g + 1] *= t1; s1[4 * g] *= t0; R *= gs * gp; }
                else { const float gs = (U0[4 * g] * U0[4 * g + 1]) * (U0[4 * g + 2] * U0[4 * g + 3]); const float gp = partner(gs, hi);
                    const float t3 = hi ? R : R * gp, t2 = t3 * U0[4 * g + 3], t1 = t2 * U0[4 * g + 2], t0 = t1 * U0[4 * g + 1];
                    s0[4 * g + 3] *= t3; s0[4 * g + 2] *= t2; s0[4 * g + 1] *= t1; s0[4 * g] *= t0; R *= gs * gp; }
            }
            carry = R;
            bf16x8 pf[4];
#pragma unroll
            for (int s = 0; s < 2; ++s) {
                v4u a, bq;
                a.x = pk2(s0[8 * s], s0[8 * s + 1]); a.y = pk2(s0[8 * s + 2], s0[8 * s + 3]); a.z = pk2(s0[8 * s + 4], s0[8 * s + 5]); a.w = pk2(s0[8 * s + 6], s0[8 * s + 7]);
                bq.x = pk2(s1[8 * s], s1[8 * s + 1]); bq.y = pk2(s1[8 * s + 2], s1[8 * s + 3]); bq.z = pk2(s1[8 * s + 4], s1[8 * s + 5]); bq.w = pk2(s1[8 * s + 6], s1[8 * s + 7]);
                pf[s] = __builtin_bit_cast(bf16x8, a); pf[2 + s] = __builtin_bit_cast(bf16x8, bq); }
#pragma unroll
            for (int ks = 0; ks < 4; ++ks) { o0 = MFMA32(vf[2 * ks], pf[ks], o0); o1 = MFMA32(vf[2 * ks + 1], pf[ks], o1); }
        }
        const int done = __all(carry == 0.f);
        if (__syncthreads_and(done) || !has_next) break;
    }
    bf16* orow = O + qrow * 1024 + (hg * 4 + hw) * 64 + 4 * hi;
#pragma unroll
    for (int g = 0; g < 4; ++g) {
        v2u a, bq; a.x = pk2(o0[4 * g], o0[4 * g + 1]); a.y = pk2(o0[4 * g + 2], o0[4 * g + 3]);
        bq.x = pk2(o1[4 * g], o1[4 * g + 1]); bq.y = pk2(o1[4 * g + 2], o1[4 * g + 3]);
        *(v2u*)(orow + 8 * g) = a; *(v2u*)(orow + 32 + 8 * g) = bq; }
    __syncthreads();
}

#define XB_TMO      128
#define XB_XCNT(j)  (256  + 64 * (j))
#define XB_XSUB(j)  (1280 + 64 * (j))
#define XB_XGEN(j)  (2304 + 64 * (j))
#define XB_TOP      3328
#define XB_TOPGEN   3392
#define XCD_BAR_WORDS 3456
#define XB_SPIN_CAP (1u << 18)

__device__ __forceinline__ unsigned xb_ld(unsigned* p)              { return __hip_atomic_load(p, __ATOMIC_RELAXED, __HIP_MEMORY_SCOPE_AGENT); }
__device__ __forceinline__ unsigned xb_add(unsigned* p, unsigned v) { return __hip_atomic_fetch_add(p, v, __ATOMIC_RELAXED, __HIP_MEMORY_SCOPE_AGENT); }
__device__ __forceinline__ unsigned xb_xcc_id() { return (unsigned)__builtin_amdgcn_s_getreg((3 << 11) | 20) & 0xFu; }
#define XB_SPIN(cond, bar) do { unsigned _sp = 0; while (cond) { __builtin_amdgcn_s_sleep(1); \
    if ((++_sp & 255u) == 0u) { if (xb_ld(&(bar)[XB_TMO])) break; if (_sp > XB_SPIN_CAP) { atomicAdd(&(bar)[XB_TMO], 1u); break; } } } } while (0)

struct XcdBarrier {
    unsigned* bar; unsigned x;
    volatile LAS unsigned* st;
};

__device__ __forceinline__ XcdBarrier xcd_barrier_post(unsigned* bar, volatile LAS unsigned* st) {
    XcdBarrier b; b.bar = bar; b.x = xb_xcc_id(); b.st = st;
    if (threadIdx.x == 0) (void)xb_add(&bar[XB_XCNT(b.x)], 1u);
    return b;
}
__device__ __forceinline__ void xcd_barrier_complete(unsigned* bar, unsigned x, unsigned& nloc, unsigned& nx) {
    const unsigned G = gridDim.x * gridDim.y * gridDim.z;
    unsigned sum, cnt, mine, sp = 0u;
    for (;;) {
        sum = 0u; cnt = 0u; mine = 0u;
#pragma unroll
        for (unsigned j = 0; j < 16; ++j) { const unsigned c = xb_ld(&bar[XB_XCNT(j)]); sum += c; cnt += (c > 0u) ? 1u : 0u; mine = (j == x) ? c : mine; }
        if (sum == G) break;
        __builtin_amdgcn_s_sleep(1);
        if ((++sp & 255u) == 0u) { if (xb_ld(&bar[XB_TMO])) break; if (sp > XB_SPIN_CAP) { atomicAdd(&bar[XB_TMO], 1u); break; } }
    }
    nloc = mine > 0u ? mine : 1u; nx = cnt > 0u ? cnt : 1u;
}

__device__ __forceinline__ void xcd_barrier(const XcdBarrier& b) {
    asm volatile("s_waitcnt vmcnt(0)" ::: "memory");
    __syncthreads();
    if (threadIdx.x == 0) {
        unsigned* bar = b.bar;
        __builtin_amdgcn_s_waitcnt(0);
        unsigned nloc = b.st[0], nx = b.st[1];
        if (nloc == 0u) { xcd_barrier_complete(bar, b.x, nloc, nx); b.st[0] = nloc; b.st[1] = nx; }
        const unsigned old = xb_add(&bar[XB_XSUB(b.x)], 1u);
        const unsigned gen = old / nloc;
        if (old + 1u == (gen + 1u) * nloc) {
            __builtin_amdgcn_fence(__ATOMIC_RELEASE, "agent");
            asm volatile("s_waitcnt vmcnt(0)" ::: "memory");
            const unsigned og = xb_add(&bar[XB_TOP], 1u);
            const unsigned tg = og / nx;
            if (og + 1u == (tg + 1u) * nx) xb_add(&bar[XB_TOPGEN], 1u);
            else XB_SPIN(xb_ld(&bar[XB_TOPGEN]) == tg, bar);
            __builtin_amdgcn_fence(__ATOMIC_ACQUIRE, "agent");
            xb_add(&bar[XB_XGEN(b.x)], 1u);
            asm volatile("s_waitcnt vmcnt(0)" ::: "memory");
        } else {
            XB_SPIN(xb_ld(&bar[XB_XGEN(b.x)]) == gen, bar);
            __builtin_amdgcn_fence(__ATOMIC_ACQUIRE, "agent");
            asm volatile("s_waitcnt vmcnt(0)" ::: "memory");
        }
    }
    __syncthreads();
}

#ifndef PROBE_P4
#define PROBE_P4 1
#endif
#ifndef PROBE_P11
#define PROBE_P11 1
#endif
#ifndef PROBE_SYNC
#define PROBE_SYNC 1
#endif
constexpr int NPH = 17;
__global__ void __launch_bounds__(512, 2) fwd(Args args) {
    extern __shared__ __attribute__((aligned(16))) unsigned char lds_raw[];
    LAS unsigned char* lds = (LAS unsigned char*)lds_raw;
    const int tid = threadIdx.x, lane = tid & 63, wave = __builtin_amdgcn_readfirstlane(tid >> 6);
    const int G = gridDim.x, bx = blockIdx.x;
    const int gw = bx * 8 + wave, NGW = G * 8;
    const size_t gt = (size_t)bx * 512 + tid, gn = (size_t)G * 512;
    unsigned char* ws = args.ws; float* out = args.out;
    const float *x_p = args.in[0], *x_s = args.in[1], *c_ckv = args.in[2], *c_kr = args.in[3], *c_bk = args.in[4], *c_bv = args.in[5], *c_sk = args.in[6], *c_sv = args.in[7];
    const float *w_in_ab = args.in[8], *g_q = args.in[9], *w_uq = args.in[10], *g_kv = args.in[11], *w_ukv = args.in[12], *rel_bias = args.in[13], *w_out_ab = args.in[14];
    const float *w_in_c = args.in[15], *w_out_c = args.in[16], *ln_mix_g = args.in[17], *ln_mix_b = args.in[18], *ln_ffn_g = args.in[19], *ln_ffn_b = args.in[20], *w_up = args.in[21], *w_down = args.in[22];
    bf16 *Wt_inab = (bf16*)(ws + W_INAB), *Wt_uq = (bf16*)(ws + W_UQ), *Wt_ukv = (bf16*)(ws + W_UKV), *Wt_outab = (bf16*)(ws + W_OUTAB), *Wt_inc = (bf16*)(ws + W_INC), *Wt_outc = (bf16*)(ws + W_OUTC);
    bf16 *Wt_up = (bf16*)(ws + W_UP), *Wt_down = (bf16*)(ws + W_DOWN);
    float* rope = (float*)(ws + W_ROPE);
    bf16 *Xb = (bf16*)(ws + W_XB), *Hb = (bf16*)(ws + W_H), *KVb = (bf16*)(ws + W_KV), *Ub = (bf16*)(ws + W_H), *Ob = Xb;
    unsigned char* ob = (unsigned char*)out;
    bf16 *QLb = (bf16*)(ob + S_QL), *QAb = (bf16*)(ob + S_QA), *CKVb = (bf16*)(ob + S_CKV), *KRb = (bf16*)(ob + S_KR), *cbk = (bf16*)(ob + S_CBK), *cbv = (bf16*)(ob + S_CBV);
    float* YF = out + O_Y; float* PARTb = (float*)(ws + W_PART); bf16* XH = (bf16*)(ws + W_XH); bf16* O1b = (bf16*)(ws + W_KV);
    cg::grid_group grid = cg::this_grid();
    const int lo = args.ph_lo, hi = args.ph_hi;
    volatile LAS unsigned* MISC = (volatile LAS unsigned*)(lds + 131072 + 320);
    if (tid < 32) MISC[tid] = 0u;
    __syncthreads();
    XcdBarrier xbar = xcd_barrier_post((unsigned*)(ws + 16384), MISC + 8);
    if (lo < 0) grid.sync();
#define IN(k) (lo <= (k) && (k) < hi)
#define SEAM(k) do { if (IN(k) && IN((k) + 1)) { for (int s_ = 0; s_ < PROBE_SYNC; ++s_) xcd_barrier(xbar); } } while (0)

    if (IN(0)) {
        LAS float* scr = (LAS float*)(lds + wave * 16384);
        constexpr int I0 = (DM / 64) * (IN_AB / 32), I1 = (768 / 64) * (768 / 32), I2 = (256 / 64) * (1024 / 32), I3 = (DM / 64) * (DM / 32), I4 = (DM / 64) * (IN_C / 32), I5 = I3,
                      I6 = (DM / 64) * (FF / 32), I7 = (FF / 64) * (DM / 32);
        constexpr int NIT = I0 + I1 + I2 + I3 + I6 + I7;
        for (int it = gw; it < NIT; it += NGW) { int r_ = it;
            if (r_ < I0) { transpose_item(w_in_ab, DM, IN_AB, Wt_inab, scr, r_, lane); continue; } r_ -= I0;
            if (r_ < I1) { transpose_item(w_uq, 768, 768, Wt_uq, scr, r_, lane, 0.10206207261596575f * LOG2E); continue; } r_ -= I1;
            if (r_ < I2) { transpose_item(w_ukv, 256, 1024, Wt_ukv, scr, r_, lane); continue; } r_ -= I2;
            if (r_ < I3) { transpose_item(w_out_ab, DM, DM, Wt_outab, scr, r_, lane); continue; } r_ -= I3;
            if (r_ < I6) { transpose_item(w_up, DM, FF, Wt_up, scr, r_, lane); continue; } r_ -= I6;
            transpose_item(w_down, FF, DM, Wt_down, scr, r_, lane);
        }
        for (size_t i = gt; i < (size_t)(IN_ABP - IN_AB) * DM / 8; i += gn) *(v4u*)(Wt_inab + (size_t)IN_AB * DM + i * 8) = (v4u){0u, 0u, 0u, 0u};
        cvt_rows(x_p, Xb, (size_t)MP * DM / 8, gt, gn);
        cvt_rows(x_s, Xb + (size_t)MP * DM, (size_t)MS * DM / 8, gt, gn);
        cvt_rows(c_ckv, CKVb + (size_t)M * 256, (size_t)DB * PAST * 256 / 8, gt, gn);
        cvt_rows(c_kr, KRb + (size_t)M * 32, (size_t)DB * PAST * 32 / 8, gt, gn);
        for (size_t i = gt; i < (size_t)SEQ * 16; i += gn) { const int pos = (int)(i >> 4), k = (int)(i & 15);
            const float inv = k == 0 ? 1.000000000e+00f : k == 1 ? 5.623413324e-01f : k == 2 ? 3.162277639e-01f : k == 3 ? 1.778279394e-01f : k == 4 ? 1.000000015e-01f : k == 5 ? 5.623413250e-02f : k == 6 ? 3.162277490e-02f : k == 7 ? 1.778279431e-02f :
                              k == 8 ? 9.999999776e-03f : k == 9 ? 5.623413250e-03f : k == 10 ? 3.162277630e-03f : k == 11 ? 1.778279431e-03f : k == 12 ? 1.000000047e-03f : k == 13 ? 5.623413017e-04f : k == 14 ? 3.162277571e-04f : 1.778279402e-04f;
            const float ang = (float)pos * inv; double tr = (double)ang * 0.15915494309189535; tr -= __builtin_floor(tr); const float fr = (float)tr;
            rope[i * 2] = __builtin_amdgcn_cosf(fr); rope[i * 2 + 1] = __builtin_amdgcn_sinf(fr); }
    }
    SEAM(0);
    if (IN(1)) { pg8::Gemm g{Xb, Wt_inab, M, IN_ABP, DM, DM}; pg8::StaticOrder S; S.init(M, IN_ABP, G, bx); pg8::EpiBf16<0> E{Hb, IN_ABP};
        pg8::gemm_phase<pg8::EpiBf16<0>, pg8::StaticOrder, true, true>(lds, g, S, E); }
    SEAM(1);
    if (IN(2)) {
#define P2_LOAD(S, m) \
        const bool ok##S = (m) < M; const int mm##S = ok##S ? (m) : 0; const bf16* hrow##S = Hb + (size_t)mm##S * IN_ABP; \
        const bool isp##S = mm##S < MP; const int ms##S = mm##S - MP; const int pos##S = isp##S ? (mm##S & (SEQ - 1)) : PAST + (ms##S & 63); \
        v2u vq##S[3]; _Pragma("unroll") for (int j = 0; j < 3; ++j) vq##S[j] = *(const v2u*)(hrow##S + lane * 4 + 256 * j); \
        const v2u vc##S = *(const v2u*)(hrow##S + 768 + lane * 4); \
        const unsigned short xr1##S = hrow##S[1024 + (lane & 15)], xr2##S = hrow##S[1040 + (lane & 15)]; \
        const float cs##S = rope[(size_t)pos##S * 32 + 2 * (lane & 15)], sn##S = rope[(size_t)pos##S * 32 + 2 * (lane & 15) + 1]; \
        float *dk##S = nullptr, *dv##S = nullptr; \
        if (isp##S) { const int t = mm##S & (SEQ - 1), b = mm##S >> 12; if (t >= SEQ - 512) { dk##S = out + O_BKP + ((size_t)b * 512 + t - (SEQ - 512)) * 512; dv##S = out + O_BVP + ((size_t)b * 512 + t - (SEQ - 512)) * 512; } } \
        else { const int b = ms##S >> 6, t = ms##S & 63; dk##S = out + O_BKS + ((size_t)b * 512 + 448 + t) * 512; dv##S = out + O_BVS + ((size_t)b * 512 + 448 + t) * 512; } \
        v4u kq##S = (v4u){0u, 0u, 0u, 0u}, vv##S = (v4u){0u, 0u, 0u, 0u}; if (dk##S) { kq##S = *(const v4u*)(hrow##S + 1568 + lane * 8); vv##S = *(const v4u*)(hrow##S + 2080 + lane * 8); }
#define P2_FIN(S) if (ok##S) { \
        { float f[12]; float ss = 0.f; \
            _Pragma("unroll") for (int j = 0; j < 3; ++j) { f[4 * j] = bflo(vq##S[j].x); f[4 * j + 1] = bfhi(vq##S[j].x); f[4 * j + 2] = bflo(vq##S[j].y); f[4 * j + 3] = bfhi(vq##S[j].y); } \
            _Pragma("unroll") for (int j = 0; j < 12; ++j) ss += f[j] * f[j]; \
            ss = wave_sum(ss); const float rs = rsqrtf(ss * (1.f / 768.f) + 1e-6f); \
            _Pragma("unroll") for (int j = 0; j < 3; ++j) { const f32x4 gv = *(const f32x4*)(g_q + lane * 4 + 256 * j); v2u o; o.x = pk2(f[4 * j] * rs * gv[0], f[4 * j + 1] * rs * gv[1]); o.y = pk2(f[4 * j + 2] * rs * gv[2], f[4 * j + 3] * rs * gv[3]); \
                *(v2u*)(QLb + (size_t)mm##S * 768 + lane * 4 + 256 * j) = o; } } \
        { const float a = bflo(vc##S.x), b = bfhi(vc##S.x), c = bflo(vc##S.y), d = bfhi(vc##S.y); \
            float ss = a * a + b * b + c * c + d * d; ss = wave_sum(ss); const float rs = rsqrtf(ss * (1.f / 256.f) + 1e-6f); \
            const f32x4 gv = *(const f32x4*)(g_kv + lane * 4); const f32x4 y = (f32x4){a * rs * gv[0], b * rs * gv[1], c * rs * gv[2], d * rs * gv[3]}; \
            float* dst = isp##S ? out + O_CKVP + (size_t)mm##S * 256 : out + O_CKVS + (size_t)ms##S * 256; *(f32x4*)(dst + lane * 4) = y; \
            v2u o; o.x = pk2(y[0], y[1]); o.y = pk2(y[2], y[3]); *(v2u*)(CKVb + (size_t)mm##S * 256 + lane * 4) = o; } \
        if (lane < 16) { const float x1 = bf1(xr1##S), x2 = bf1(xr2##S); \
            const float y1 = x1 * cs##S - x2 * sn##S, y2 = x2 * cs##S + x1 * sn##S; float* dst = isp##S ? out + O_KRP + (size_t)mm##S * 32 : out + O_KRS + (size_t)ms##S * 32; dst[lane] = y1; dst[lane + 16] = y2; \
            KRb[(size_t)mm##S * 32 + lane] = (bf16)f2bf(y1); KRb[(size_t)mm##S * 32 + 16 + lane] = (bf16)f2bf(y2); } \
        if (dk##S) { \
            *(f32x4*)(dk##S + lane * 8) = (f32x4){bflo(kq##S.x), bfhi(kq##S.x), bflo(kq##S.y), bfhi(kq##S.y)}; *(f32x4*)(dk##S + lane * 8 + 4) = (f32x4){bflo(kq##S.z), bfhi(kq##S.z), bflo(kq##S.w), bfhi(kq##S.w)}; \
            *(f32x4*)(dv##S + lane * 8) = (f32x4){bflo(vv##S.x), bfhi(vv##S.x), bflo(vv##S.y), bfhi(vv##S.y)}; *(f32x4*)(dv##S + lane * 8 + 4) = (f32x4){bflo(vv##S.z), bfhi(vv##S.z), bflo(vv##S.w), bfhi(vv##S.w)}; } }
        for (int m = gw; m < M; m += 4 * NGW) {
            P2_LOAD(A, m) P2_LOAD(B, m + NGW) P2_LOAD(C, m + 2 * NGW) P2_LOAD(D, m + 3 * NGW)
            P2_FIN(A) P2_FIN(B) P2_FIN(C) P2_FIN(D)
        }
#undef P2_LOAD
#undef P2_FIN
    }
    SEAM(2);
    if (IN(3)) {
        { pg8::Gemm g{QLb, Wt_uq, M, 768, 768, 768}; pg8::StaticOrder S; S.init(M, 768, G, bx); pg8::EpiBf16<0> E{QAb, 768};
          pg8::gemm_phase<pg8::EpiBf16<0>, pg8::StaticOrder, true, true>(lds, g, S, E); }
        { pg8::Gemm g{CKVb, Wt_ukv, MKV, 1024, 256, 256}; pg8::StaticOrder S; S.init(MKV, 1024, G, G - 1 - bx); pg8::EpiBf16<0> E{KVb, 1024};
          pg8::gemm_phase<pg8::EpiBf16<0>, pg8::StaticOrder, true, true>(lds, g, S, E); }
    }
    SEAM(3);
    for (int rep_ = 0; rep_ < PROBE_P4; ++rep_) if (IN(4)) {
        constexpr int NU = 2560;
        for (int rd = 0; rd * G < NU; ++rd) { const int i = rd * G + ((rd & 1) ? (G - 1 - bx) : bx); if (i >= NU) continue;
            att::AU U; U.kAf = nullptr; U.vAf = nullptr;
            if (i < 1024) { const int qb = 15 - (i >> 6), bh = i & 63, b = bh >> 3, h = bh & 7; const size_t r0 = (size_t)b * SEQ, rq = r0 + qb * 256;
                U.q = QAb + rq * 768 + h * 96; U.qp = 768; U.kA = KVb + r0 * 1024 + h * 128; U.vA = U.kA + 64; U.rA = KRb + r0 * 32; U.pA = 1024; U.kB = U.kA; U.vB = U.vA; U.rB = U.rA; U.pB = 1024;
                U.o = Ob + rq * 1024 + h * 64; U.op = 1024; U.ntA = 1 << 30; U.nrows = 256; U.qpos0 = qb * 256; U.h = h;
                att::attn_unit<0>(U, lds, rope, rel_bias); }
            else if (i < 2048) { const int j = i - 1024, qb = 15 - (j >> 6), bh = j & 63, b = bh >> 3, h = bh & 7; const size_t r0 = (size_t)b * SEQ, rq = r0 + qb * 256;
                U.q = Hb + rq * IN_ABP + 1056 + h * 64; U.qp = IN_ABP; U.kA = Hb + r0 * IN_ABP + 1568 + h * 64; U.vA = Hb + r0 * IN_ABP + 2080 + h * 64; U.rA = nullptr; U.pA = IN_ABP; U.kB = U.kA; U.vB = U.vA; U.rB = nullptr; U.pB = IN_ABP;
                U.o = Ob + rq * 1024 + 512 + h * 64; U.op = 1024; U.ntA = 1 << 30; U.nrows = 256; U.qpos0 = qb * 256; U.h = h;
                att::attn_unit<1>(U, lds, rope, rel_bias); }
            else if (i < 2304) { const int j = i - 2048, b = j >> 3, h = j & 7; const size_t rn = (size_t)MP + b * 64, rc = (size_t)M + (size_t)b * PAST;
                U.q = QAb + rn * 768 + h * 96; U.qp = 768; U.kA = KVb + rc * 1024 + h * 128; U.vA = U.kA + 64; U.rA = KRb + rc * 32; U.pA = 1024;
                U.kB = KVb + rn * 1024 + h * 128; U.vB = U.kB + 64; U.rB = KRb + rn * 32; U.pB = 1024;
                U.o = Ob + rn * 1024 + h * 64; U.op = 1024; U.ntA = 16; U.nrows = 64; U.qpos0 = PAST; U.h = h;
                att::attn_unit<0>(U, lds, rope, rel_bias); }
            else { const int j = i - 2304, b = j >> 3, h = j & 7; const size_t rn = (size_t)MP + b * 64;
                U.q = Hb + rn * IN_ABP + 1056 + h * 64; U.qp = IN_ABP; U.kA = nullptr; U.vA = nullptr; U.kAf = c_bk + (size_t)b * 512 * 512 + h * 64; U.vAf = c_bv + (size_t)b * 512 * 512 + h * 64; U.rA = nullptr; U.pA = 512;
                U.kB = Hb + rn * IN_ABP + 1568 + h * 64; U.vB = Hb + rn * IN_ABP + 2080 + h * 64; U.rB = nullptr; U.pB = IN_ABP;
                U.o = Ob + rn * 1024 + 512 + h * 64; U.op = 1024; U.ntA = 8; U.nrows = 64; U.qpos0 = 512; U.h = h;
                att::attn_unit<1>(U, lds, rope, rel_bias); }
        }
    }
    SEAM(4);
    if (IN(5)) { { pg8::Gemm g{Ob, Wt_outab, MP, DM, 1024, 1024}; pg8::StaticOrder S; S.init(MP, DM, G, bx); pg8::EpiResH<true> E{x_p, XH, DM, ALPHA};
          pg8::gemm_phase<pg8::EpiResH<true>, pg8::StaticOrder, true, true>(lds, g, S, E); }
        { pg8::Gemm g{Ob, Wt_outab, M, DM, 256, 1024}; pg8::SplitOrder S{MP / 256, DM / 256, 4, 256, 128, bx, G}; pg8::EpiPart E{PARTb, MP / 256, 256, MS, DM};
          pg8::gemm_phase<pg8::EpiPart, pg8::SplitOrder, true, true>(lds, g, S, E); } }
    SEAM(5);
#define LN_LOAD(v, m) do { if ((m) < MP) { _Pragma("unroll") for (int j = 0; j < 4; ++j) { const v2u q_ = *(const v2u*)(XH + (size_t)(m) * DM + lane * 4 + 256 * j); v[j] = (f32x4){bflo(q_.x), bfhi(q_.x), bflo(q_.y), bfhi(q_.y)}; } } \
        else if ((m) < M) { const size_t r_ = (size_t)((m) - MP); \
            if (RSF_) { _Pragma("unroll") for (int j = 0; j < 4; ++j) v[j] = *(const f32x4*)((RSF_) + r_ * DM + lane * 4 + 256 * j) * ALPHA; } \
            else { _Pragma("unroll") for (int j = 0; j < 4; ++j) { const v2u q_ = *(const v2u*)(Xb + (size_t)(m) * DM + lane * 4 + 256 * j); v[j] = (f32x4){bflo(q_.x), bfhi(q_.x), bflo(q_.y), bfhi(q_.y)} * ALPHA; } } \
            for (int ks = 0; ks < NSP_; ++ks) { const float* pp = PARTb + ((size_t)ks * MS + r_) * DM; _Pragma("unroll") for (int j = 0; j < 4; ++j) v[j] += *(const f32x4*)(pp + lane * 4 + 256 * j); } } \
        else { _Pragma("unroll") for (int j = 0; j < 4; ++j) v[j] = (f32x4){0.f, 0.f, 0.f, 0.f}; } } while (0)
#define LN_FINISH(v, m, gam, bet, FIN) do { float s = 0.f, s2 = 0.f; \
        _Pragma("unroll") for (int j = 0; j < 4; ++j) { s += (v[j][0] + v[j][1]) + (v[j][2] + v[j][3]); s2 += (v[j][0] * v[j][0] + v[j][1] * v[j][1]) + (v[j][2] * v[j][2] + v[j][3] * v[j][3]); } \
        const float mean = wave_sum(s) * (1.f / DM); const float var = fmaxf(wave_sum(s2) * (1.f / DM) - mean * mean, 0.f);     \
        _Pragma("unroll") for (int j = 0; j < 4; ++j) v[j] = v[j] - mean; \
        const float rstd = rsqrtf(var + 1e-5f); \
        if ((m) < M) { _Pragma("unroll") for (int j = 0; j < 4; ++j) { const f32x4 gv = *(const f32x4*)((gam) + lane * 4 + 256 * j), bv = *(const f32x4*)((bet) + lane * 4 + 256 * j); \
            const f32x4 y = v[j] * rstd * gv + bv; \
            if (FIN) *(f32x4*)(YF + (size_t)(m) * DM + lane * 4 + 256 * j) = y; \
            else { v2u o; o.x = pk2(y[0], y[1]); o.y = pk2(y[2], y[3]); *(v2u*)(Xb + (size_t)(m) * DM + lane * 4 + 256 * j) = o; } } } } while (0)
#define LN_PHASE(gam, bet, RSF, NS_, FIN) do { const float* RSF_ = (RSF); const int NSP_ = (NS_); \
        for (int m = gw; m < M; m += 4 * NGW) { const int mb = m + NGW, mc = m + 2 * NGW, md = m + 3 * NGW; f32x4 va[4], vb[4], vc[4], vd[4]; LN_LOAD(va, m); LN_LOAD(vb, mb); LN_LOAD(vc, mc); LN_LOAD(vd, md); \
            LN_FINISH(va, m, gam, bet, FIN); LN_FINISH(vb, mb, gam, bet, FIN); LN_FINISH(vc, mc, gam, bet, FIN); LN_FINISH(vd, md, gam, bet, FIN); } } while (0)
    if (IN(6)) LN_PHASE(ln_mix_g, ln_mix_b, x_s, 4, false);
    SEAM(6);
    if (IN(7)) { pg8::Gemm g{Xb, Wt_up, M, FF, DM, DM}; pg8::StaticOrder S; S.init(M, FF, G, bx); pg8::EpiBf16<2> E{Ub, FF};
        pg8::gemm_phase<pg8::EpiBf16<2>, pg8::StaticOrder, true, true>(lds, g, S, E);
        { const bool half = (G == 256); if (!half || bx >= 128) { const int gwx = half ? (bx - 128) * 8 + wave : gw, ngx = half ? 128 * 8 : NGW;
            LAS float* scr = (LAS float*)(lds + wave * 16384);
            constexpr int J4 = (DM / 64) * (IN_C / 32), J5 = (DM / 64) * (DM / 32), J6 = (DM / 64) * (FF / 32), J7 = (FF / 64) * (DM / 32);
            for (int it = gwx; it < J4 + J5 + J6 + J7; it += ngx) { int r_ = it;
                if (r_ < J4) { transpose_item(w_in_c, DM, IN_C, Wt_inc, scr, r_, lane, 0.125f * LOG2E, 1024); continue; } r_ -= J4;
                if (r_ < J5) { transpose_item(w_out_c, DM, DM, Wt_outc, scr, r_, lane); continue; } r_ -= J5;
                if (r_ < J6) { transpose_item(w_up + (size_t)DM * FF, DM, FF, Wt_up + (size_t)DM * FF, scr, r_, lane); continue; } r_ -= J6;
                transpose_item(w_down + (size_t)DM * FF, FF, DM, Wt_down + (size_t)DM * FF, scr, r_, lane); } } } }
    SEAM(7);
    if (IN(8)) { { pg8::Gemm g{Ub, Wt_down, MP, DM, 4096, 4096}; pg8::StaticOrder S; S.init(MP, DM, G, bx); pg8::EpiResH<false> E{Xb, XH, DM, ALPHA};
          pg8::gemm_phase<pg8::EpiResH<false>, pg8::StaticOrder, true, true>(lds, g, S, E); }
        { pg8::Gemm g{Ub, Wt_down, M, DM, 512, 4096}; pg8::SplitOrder S{MP / 256, DM / 256, 8, 512, 256, bx, G}; pg8::EpiPart E{PARTb, MP / 256, 512, MS, DM};
          pg8::gemm_phase<pg8::EpiPart, pg8::SplitOrder, true, true>(lds, g, S, E); } }
    SEAM(8);
    if (IN(9)) { LN_PHASE(ln_ffn_g, ln_ffn_b, (const float*)nullptr, 8, false); }
    SEAM(9);
    if (IN(10)) { pg8::Gemm g{Xb, Wt_inc, M, IN_C, DM, DM}; pg8::StaticOrder S; S.init(M, IN_C, G, bx); typedef pg8::EpiQKV<O_SKP, O_SVP, O_SKS, O_SVS, MP, IN_C> EQ; EQ E{Hb, out};
        pg8::gemm_phase<EQ, pg8::StaticOrder, true, true>(lds, g, S, E);
        { const bool part = (G == 256); if (!part || bx >= 96) { const size_t gtx = part ? (size_t)(bx - 96) * 512 + tid : gt, gnx = part ? (size_t)160 * 512 : gn;
        for (size_t i = gtx; i < (size_t)DB * 448 * 128; i += gnx) { const size_t b = i / (448 * 128), rem = i % (448 * 128);
            *(f32x4*)(out + O_BKS + b * 512 * 512 + rem * 4) = *(const f32x4*)(c_bk + b * 512 * 512 + 64 * 512 + rem * 4);
            *(f32x4*)(out + O_BVS + b * 512 * 512 + rem * 4) = *(const f32x4*)(c_bv + b * 512 * 512 + 64 * 512 + rem * 4); }
        } } }
    SEAM(10);
    for (int rep_ = 0; rep_ < PROBE_P11; ++rep_) if (IN(11)) {
        constexpr int NU = 2048 + 128;
        for (int i = bx; i < NU; i += G) {
            if (i < 2048) sb_unit4<false>(Hb, c_sk, c_sv, O1b, i >> 8, (i >> 2) & 63, i & 3, lds);
            else { const int j = i - 2048; sb_unit4<true>(Hb, c_sk, c_sv, O1b, j >> 2, 0, j & 3, lds); }
        }
    }
    SEAM(11);
    if (IN(12)) { { pg8::Gemm g{O1b, Wt_outc, MP, DM, 1024, 1024}; pg8::StaticOrder S; S.init(MP, DM, G, bx); pg8::EpiResH<false> E{Xb, XH, DM, ALPHA};
          pg8::gemm_phase<pg8::EpiResH<false>, pg8::StaticOrder, true, true>(lds, g, S, E); }
        { pg8::Gemm g{O1b, Wt_outc, M, DM, 256, 1024}; pg8::SplitOrder S{MP / 256, DM / 256, 4, 256, 128, bx, G}; pg8::EpiPart E{PARTb, MP / 256, 256, MS, DM};
          pg8::gemm_phase<pg8::EpiPart, pg8::SplitOrder, true, true>(lds, g, S, E); } }
    SEAM(12);
    if (IN(13)) LN_PHASE(ln_mix_g + DM, ln_mix_b + DM, (const float*)nullptr, 4, false);
    SEAM(13);
    if (IN(14)) { pg8::Gemm g{Xb, Wt_up + (size_t)DM * FF, M, FF, DM, DM}; pg8::StaticOrder S; S.init(M, FF, G, bx); pg8::EpiBf16<2> E{Ub, FF};
        pg8::gemm_phase<pg8::EpiBf16<2>, pg8::StaticOrder, true, true>(lds, g, S, E); }
    SEAM(14);
    if (IN(15)) { { pg8::Gemm g{Ub, Wt_down + (size_t)DM * FF, MP, DM, 4096, 4096}; pg8::StaticOrder S; S.init(MP, DM, G, bx); pg8::EpiResH<false> E{Xb, XH, DM, ALPHA};
          pg8::gemm_phase<pg8::EpiResH<false>, pg8::StaticOrder, true, true>(lds, g, S, E); }
        { pg8::Gemm g{Ub, Wt_down + (size_t)DM * FF, M, DM, 512, 4096}; pg8::SplitOrder S{MP / 256, DM / 256, 8, 512, 256, bx, G}; pg8::EpiPart E{PARTb, MP / 256, 512, MS, DM};
          pg8::gemm_phase<pg8::EpiPart, pg8::SplitOrder, true, true>(lds, g, S, E); } }
    SEAM(15);
    if (IN(16)) LN_PHASE(ln_ffn_g + DM, ln_ffn_b + DM, (const float*)nullptr, 8, true);
#undef IN
#undef SEAM
}

#ifndef MK_MULTI
#define MK_MULTI 0
#endif
extern "C" void kernel_launch(void* const* d_in, const int* in_sizes, int n_in, void* d_out, int out_size, void* d_ws, size_t ws_size, hipStream_t stream) {
    static int grid = 0;
    if (grid == 0) {
        if (n_in != 23 || (size_t)out_size != O_END || ws_size < W_END2) { fprintf(stderr, "kernel_launch: unexpected shapes: n_in %d out %d ws %zu (need %zu)\n", n_in, out_size, ws_size, (size_t)W_END); grid = -1; return; }
        int dev = 0, cus = 0, per_cu = 0;
        hipGetDevice(&dev); hipDeviceGetAttribute(&cus, hipDeviceAttributeMultiprocessorCount, dev);
        if (hipFuncSetAttribute((const void*)fwd, hipFuncAttributeMaxDynamicSharedMemorySize, LDS_BYTES) != hipSuccess) { fprintf(stderr, "kernel_launch: hipFuncSetAttribute failed\n"); grid = -1; return; }
        if (hipOccupancyMaxActiveBlocksPerMultiprocessor(&per_cu, (const void*)fwd, 512, LDS_BYTES) != hipSuccess || per_cu < 1) { fprintf(stderr, "kernel_launch: occupancy query says %d\n", per_cu); per_cu = 1; }
        (void)hipGetLastError();
        grid = cus;
    }
    if (grid < 0) return;
    if (hipMemsetAsync(d_ws, 0, 65536, stream) != hipSuccess) { fprintf(stderr, "kernel_launch: memset failed\n"); return; }
    Args a{};
    for (int i = 0; i < 23; ++i) a.in[i] = (const float*)d_in[i];
    a.out = (float*)d_out; a.ws = (unsigned char*)d_ws;
#if MK_MULTI
    for (int p = 0; p < NPH; ++p) { a.ph_lo = p; a.ph_hi = p + 1; hipLaunchKernelGGL(fwd, dim3(grid), dim3(512), LDS_BYTES, stream, a); }
#else
    a.ph_lo = 0; a.ph_hi = NPH;
    void* kargs[] = {&a};
    hipError_t e = hipLaunchCooperativeKernel((const void*)fwd, dim3(grid), dim3(512), kargs, LDS_BYTES, stream);
    if (e != hipSuccess) fprintf(stderr, "cooperative launch failed: %s (grid %d)\n", hipGetErrorString(e), grid);
#endif
}
```

```cpp
#include <hip/hip_runtime.h>
#include <hip/hip_bf16.h>
namespace pg8 {
#define PG8_LAS __attribute__((address_space(3)))
typedef unsigned short bf16_t;
typedef short bf16x8 __attribute__((ext_vector_type(8)));
typedef float f32x4 __attribute__((ext_vector_type(4)));
typedef unsigned u32x4 __attribute__((ext_vector_type(4)));
constexpr int BM = 256, BK = 64, HALF = 128, HTB = HALF * BK * 2  , STAGE_BYTES = 8 * HTB, NXCD = 8, WGM = 8;

__host__ __device__ __forceinline__ int lds_byte(int r, int c) { const int st = (r >> 4) * 2 + (c >> 5), rr = r & 15, cc = c & 31, ob = rr * 64 + cc * 2; return st * 1024 + (ob ^ (((ob >> 9) & 1) << 5)); }
__host__ __device__ __forceinline__ void stage_rc(int b, int& R, int& C) { const int st = b / 1024, sb = b % 1024, swz = sb ^ (((sb >> 9) & 1) << 5); R = (st >> 1) * 16 + swz / 64; C = (st & 1) * 32 + (swz % 64) / 2; }
__host__ __device__ __forceinline__ int perm32(int rho) { const int n = rho >> 4, i = rho & 15; return 8 * (i >> 2) + 4 * n + (i & 3); }

struct Unit { int pm, pn, ko; };
struct Gemm { const bf16_t* A; const bf16_t* Bt; int M, N, K, ld; };

struct StaticOrder {
    int nM, nN, nwg, G, c;
    __host__ __device__ void init(int M, int N, int G_, int c_) { nM = M / BM; nN = N / BM; nwg = nM * nN; G = G_; c = c_; }
    __host__ __device__ bool next(int i, Unit& u) const {
        const long L = (long)i * G + c; if (L >= nwg) return false;
        int wgid = (int)L; { const int q = nwg / NXCD, r = nwg % NXCD, xcd = wgid % NXCD, off = wgid / NXCD; wgid = (xcd < r ? xcd * (q + 1) : r * (q + 1) + (xcd - r) * q) + off; }
        const int nig = WGM * nN, gid = wgid / nig, fm = gid * WGM, gsz = (nM - fm) < WGM ? (nM - fm) : WGM;
        u.pm = fm + ((wgid % nig) % gsz); u.pn = (wgid % nig) / gsz; u.ko = 0; return true;
    }
    __device__ __forceinline__ void a_ready(const Unit&) const {}
    __device__ __forceinline__ void done(const Unit&) const {}
};
typedef float f32x2 __attribute__((ext_vector_type(2))); typedef __bf16 bf16x2v __attribute__((ext_vector_type(2)));
__device__ __forceinline__ unsigned cvt_pk_bf16(float lo, float hi) { f32x2 v = {lo, hi}; bf16x2v b = __builtin_convertvector(v, bf16x2v); return __builtin_bit_cast(unsigned, b); }
template <int ACT  > struct EpiBf16 {
    static constexpr bool PERM = true, AFTER_DRAIN = false;
    bf16_t* O; int ldc;
    __device__ __forceinline__ void operator()(const f32x4 (&acc)[2][2][4][2], const Unit& u, int wr, int wc, int fr, int fq) const {
        const int row0 = u.pm * BM + wr * 64 + fr; const int col0 = u.pn * BM + wc * 32 + 8 * fq;
#pragma unroll
        for (int ai = 0; ai < 2; ++ai)
#pragma unroll
            for (int m = 0; m < 4; ++m) { bf16_t* rowp = O + (size_t)(row0 + ai * HALF + m * 16) * ldc + col0;
#pragma unroll
                for (int bj = 0; bj < 2; ++bj) { f32x4 v0 = acc[ai][bj][m][0], v1 = acc[ai][bj][m][1];
                    if (ACT == 2) {
#pragma unroll
                        for (int e = 0; e < 4; ++e) { float a = fmaxf(v0[e], 0.f), b = fmaxf(v1[e], 0.f); v0[e] = a * a; v1[e] = b * b; } }
                    u32x4 w; w.x = cvt_pk_bf16(v0[0], v0[1]); w.y = cvt_pk_bf16(v0[2], v0[3]); w.z = cvt_pk_bf16(v1[0], v1[1]); w.w = cvt_pk_bf16(v1[2], v1[3]);
                    *(u32x4*)(rowp + bj * HALF) = w; } }
    }
};
struct EpiResF32 {
    static constexpr bool PERM = false, AFTER_DRAIN = false;
    const float* r0; const float* r1; int split; float* out; int ldc; float alpha;
    __device__ __forceinline__ void operator()(const f32x4 (&acc)[2][2][4][2], const Unit& u, int wr, int wc, int fr, int fq) const {
        const int col0 = u.pn * BM + wc * 32 + 4 * fq;
#pragma unroll
        for (int ai = 0; ai < 2; ++ai)
#pragma unroll
            for (int m = 0; m < 4; ++m) { const int row = u.pm * BM + ai * HALF + wr * 64 + m * 16 + fr;
                const float* rp = (row < split) ? r0 + (size_t)row * ldc : r1 + (size_t)(row - split) * ldc;
                float* op = out + (size_t)row * ldc;
#pragma unroll
                for (int bj = 0; bj < 2; ++bj)
#pragma unroll
                    for (int n = 0; n < 2; ++n) { const int c = col0 + bj * HALF + n * 16; const f32x4 rv = *(const f32x4*)(rp + c);
                        *(f32x4*)(op + c) = rv * alpha + acc[ai][bj][m][n]; } }
    }
};
template <size_t KP, size_t VP, size_t KS, size_t VS, int split, int ldc> struct EpiQKV {
    static constexpr bool PERM = true, AFTER_DRAIN = false;
    bf16_t* O; float* outp;
    __device__ __forceinline__ void operator()(const f32x4 (&acc)[2][2][4][2], const Unit& u, int wr, int wc, int fr, int fq) const {
        const int row0 = u.pm * BM + wr * 64 + fr; const int col0 = u.pn * BM + wc * 32 + 8 * fq;
        const int sel = u.pn >> 2;
        if (sel) {
            float* fbase = outp + (sel == 1 ? (u.pm * BM < split ? KP : KS) : (u.pm * BM < split ? VP : VS));
            fbase += (size_t)(row0 - (u.pm * BM < split ? 0 : split)) * 1024 + (col0 - sel * 1024);
#pragma unroll
            for (int ai = 0; ai < 2; ++ai)
#pragma unroll
                for (int m = 0; m < 4; ++m) { float* frow = fbase + (ai * HALF + m * 16) * 1024;
#pragma unroll
                    for (int bj = 0; bj < 2; ++bj) { *(f32x4*)(frow + bj * HALF) = acc[ai][bj][m][0]; *(f32x4*)(frow + bj * HALF + 4) = acc[ai][bj][m][1]; }
                    asm volatile("" ::: "memory"); }
        }
        bf16_t* obase = O + (size_t)row0 * ldc + col0;
#pragma unroll
        for (int ai = 0; ai < 2; ++ai)
#pragma unroll
            for (int m = 0; m < 4; ++m) { bf16_t* rowp = obase + (size_t)(ai * HALF + m * 16) * ldc;
#pragma unroll
                for (int bj = 0; bj < 2; ++bj) { const f32x4 v0 = acc[ai][bj][m][0], v1 = acc[ai][bj][m][1];
                    u32x4 w; w.x = cvt_pk_bf16(v0[0], v0[1]); w.y = cvt_pk_bf16(v0[2], v0[3]); w.z = cvt_pk_bf16(v1[0], v1[1]); w.w = cvt_pk_bf16(v1[2], v1[3]);
                    *(u32x4*)(rowp + bj * HALF) = w; }
                asm volatile("" ::: "memory"); }
    }
};
struct SplitOrder {
    int pm0, nN, S, Ksub, nunits, c, G;
    __device__ __forceinline__ bool next(int i, Unit& u) const { const int L = i * G + c; if (L >= nunits) return false; const int t = L / S, ks = L % S; u.pm = pm0 + t / nN; u.pn = t % nN; u.ko = ks * Ksub; return true; }
    __device__ __forceinline__ void a_ready(const Unit&) const {}
    __device__ __forceinline__ void done(const Unit&) const {}
};
struct EpiPart {
    static constexpr bool PERM = false, AFTER_DRAIN = false;
    float* part; int pm0, Ksub, rows, ldc;
    __device__ __forceinline__ void operator()(const f32x4 (&acc)[2][2][4][2], const Unit& u, int wr, int wc, int fr, int fq) const {
        const int col0 = u.pn * BM + wc * 32 + 4 * fq; float* base = part + ((size_t)(u.ko / Ksub) * rows + (size_t)(u.pm - pm0) * BM) * ldc;
#pragma unroll
        for (int ai = 0; ai < 2; ++ai)
#pragma unroll
            for (int m = 0; m < 4; ++m) { float* op = base + (size_t)(ai * HALF + wr * 64 + m * 16 + fr) * ldc;
#pragma unroll
                for (int bj = 0; bj < 2; ++bj)
#pragma unroll
                    for (int n = 0; n < 2; ++n) *(f32x4*)(op + col0 + bj * HALF + n * 16) = acc[ai][bj][m][n]; }
    }
};
template <bool RF32> struct EpiResH {
    static constexpr bool PERM = true, AFTER_DRAIN = false;
    const void* res; bf16_t* out; int ldc; float alpha;
    __device__ __forceinline__ void operator()(const f32x4 (&acc)[2][2][4][2], const Unit& u, int wr, int wc, int fr, int fq) const {
        const int row0 = u.pm * BM + wr * 64 + fr; const int col0 = u.pn * BM + wc * 32 + 8 * fq;
#pragma unroll
        for (int ai = 0; ai < 2; ++ai)
#pragma unroll
            for (int m = 0; m < 4; ++m) { const size_t off = (size_t)(row0 + ai * HALF + m * 16) * ldc + col0;
#pragma unroll
                for (int bj = 0; bj < 2; ++bj) { f32x4 r0, r1;
                    if (RF32) { r0 = *(const f32x4*)((const float*)res + off + bj * HALF); r1 = *(const f32x4*)((const float*)res + off + bj * HALF + 4); }
                    else { const u32x4 q = *(const u32x4*)((const bf16_t*)res + off + bj * HALF);
                        r0 = (f32x4){__builtin_bit_cast(float, q.x << 16), __builtin_bit_cast(float, q.x & 0xffff0000u), __builtin_bit_cast(float, q.y << 16), __builtin_bit_cast(float, q.y & 0xffff0000u)};
                        r1 = (f32x4){__builtin_bit_cast(float, q.z << 16), __builtin_bit_cast(float, q.z & 0xffff0000u), __builtin_bit_cast(float, q.w << 16), __builtin_bit_cast(float, q.w & 0xffff0000u)}; }
                    const f32x4 v0 = r0 * alpha + acc[ai][bj][m][0], v1 = r1 * alpha + acc[ai][bj][m][1];
                    u32x4 w; w.x = cvt_pk_bf16(v0[0], v0[1]); w.y = cvt_pk_bf16(v0[2], v0[3]); w.z = cvt_pk_bf16(v1[0], v1[1]); w.w = cvt_pk_bf16(v1[2], v1[3]);
                    *(u32x4*)(out + off + bj * HALF) = w; }
                if (m & 1) asm volatile("" ::: "memory"); }
    }
};
template <class Epi, class Sched, bool ALIGN_EPI = false, bool SP2 = false>
__device__ __forceinline__ void gemm_phase(PG8_LAS unsigned char* lds, const Gemm g, const Sched& S, const Epi& E) {
    const int tid = threadIdx.x, wid = __builtin_amdgcn_readfirstlane(tid >> 6), lane = tid & 63, wr = wid >> 2, wc = wid & 3, fr = lane & 15, fq = lane >> 4;
    const int K = g.K, LD = g.ld, nt = K / BK;
    unsigned voffA[2], voffB[2];
#pragma unroll
    for (int i = 0; i < 2; ++i) { int R, C; stage_rc(tid * 16 + i * 8192, R, C); const int Rb = Epi::PERM ? ((R & ~31) + perm32(R & 31)) : R;
        voffA[i] = (unsigned)(R * LD + C) * 2u; voffB[i] = (unsigned)(Rb * LD + C) * 2u; }
    const size_t kstep = (size_t)(BK * 2);
    const size_t hstep = (size_t)HALF * LD * 2;
    const size_t tstep = 2 * hstep;
    const unsigned ldsw = (unsigned)wid * 1024u;
    const int aoff = lds_byte(wr * 64 + fr, fq * 8), boff = lds_byte(wc * 32 + fr, fq * 8);
#define PG8_SA(b, h) (((b) * 2 + (h)) * HTB)
#define PG8_SB(b, h) ((4 + (b) * 2 + (h)) * HTB)
#define PG8_STAGE(bufoff, gbase, voff) do { _Pragma("unroll") for (int _i = 0; _i < 2; ++_i) \
        __builtin_amdgcn_global_load_lds((const unsigned*)((const char*)(gbase) + (voff)[_i]), (PG8_LAS unsigned*)(lds + (bufoff) + ldsw + _i * 8192), 16, 0, 0); } while (0)
#define PG8_LDA(dst, b, h) do { _Pragma("unroll") for (int m = 0; m < 4; ++m) _Pragma("unroll") for (int k = 0; k < 2; ++k) dst[m][k] = *(const PG8_LAS bf16x8*)(lds + PG8_SA(b, h) + aoff + m * 2048 + k * 1024); } while (0)
#define PG8_LDB(dst, b, h) do { _Pragma("unroll") for (int n = 0; n < 2; ++n) _Pragma("unroll") for (int k = 0; k < 2; ++k) dst[n][k] = *(const PG8_LAS bf16x8*)(lds + PG8_SB(b, h) + boff + n * 2048 + k * 1024); } while (0)
#define PG8_MMA(ai, bj, At, Bt) do { __builtin_amdgcn_s_setprio(1); _Pragma("unroll") for (int m = 0; m < 4; ++m) _Pragma("unroll") for (int n = 0; n < 2; ++n) _Pragma("unroll") for (int k = 0; k < 2; ++k) \
        acc[ai][bj][m][n] = __builtin_amdgcn_mfma_f32_16x16x32_bf16(Bt[n][k], At[m][k], acc[ai][bj][m][n], 0, 0, 0); __builtin_amdgcn_s_setprio(0); } while (0)
#define PG8_WAIT_V(n) asm volatile("s_waitcnt vmcnt(" #n ")" ::: "memory")
#define PG8_WAIT_L(n) asm volatile("s_waitcnt lgkmcnt(" #n ")" ::: "memory")
#define PG8_BAR __builtin_amdgcn_s_barrier()
#define PG8_SCHED __builtin_amdgcn_sched_barrier(0)
    Unit cur, nxt; int ui = 0;
    if (!S.next(0, cur)) return;
    f32x4 acc[2][2][4][2];
#pragma unroll
    for (int a = 0; a < 2; ++a)
#pragma unroll
        for (int b = 0; b < 2; ++b)
#pragma unroll
            for (int m = 0; m < 4; ++m)
#pragma unroll
                for (int n = 0; n < 2; ++n) acc[a][b][m][n] = (f32x4){0.f, 0.f, 0.f, 0.f};
    bf16x8 At[4][2], B0[2][2], B1[2][2];
    const char* cA = (const char*)g.A + (size_t)cur.pm * tstep + (size_t)cur.ko * 2; const char* cB = (const char*)g.Bt + (size_t)cur.pn * tstep + (size_t)cur.ko * 2;
    S.a_ready(cur);
    if constexpr (SP2) {
        PG8_STAGE(PG8_SB(0, 0), cB, voffB); PG8_STAGE(PG8_SB(0, 1), cB + hstep, voffB); PG8_STAGE(PG8_SA(0, 0), cA, voffA); PG8_STAGE(PG8_SA(0, 1), cA + hstep, voffA);
        if (wr == 1) PG8_BAR;
        PG8_WAIT_V(2); PG8_BAR;
        PG8_STAGE(PG8_SB(1, 0), cB + kstep, voffB); PG8_STAGE(PG8_SA(1, 0), cA + kstep, voffA); PG8_STAGE(PG8_SB(1, 1), cB + hstep + kstep, voffB);
        PG8_WAIT_V(6); PG8_BAR;
    } else {
        PG8_STAGE(PG8_SB(0, 0), cB, voffB); PG8_STAGE(PG8_SA(0, 0), cA, voffA); PG8_STAGE(PG8_SB(0, 1), cB + hstep, voffB); PG8_STAGE(PG8_SA(0, 1), cA + hstep, voffA);
        if (wr == 1) PG8_BAR;
        PG8_WAIT_V(4); PG8_BAR;
        PG8_STAGE(PG8_SB(1, 0), cB + kstep, voffB); PG8_STAGE(PG8_SA(1, 0), cA + kstep, voffA); PG8_STAGE(PG8_SB(1, 1), cB + hstep + kstep, voffB);
        PG8_WAIT_V(6); PG8_BAR;
    }
    for (;;) {
        const bool has_next = S.next(ui + 1, nxt);
        const char* nA = has_next ? (const char*)g.A + (size_t)nxt.pm * tstep + (size_t)nxt.ko * 2 : cA; const char* nB = has_next ? (const char*)g.Bt + (size_t)nxt.pn * tstep + (size_t)nxt.ko * 2 : cB;
        for (int t = 0; t < nt; t += 2) {
            const bool last = (t == nt - 2);
            const char* a1 = cA + (size_t)(t + 1) * kstep;
            const char* a2 = last ? nA : cA + (size_t)(t + 2) * kstep; const char* b2 = last ? nB : cB + (size_t)(t + 2) * kstep;
            const char* a3 = a2 + kstep; const char* b3 = b2 + kstep;
            if (last && has_next) S.a_ready(nxt);
            if constexpr (SP2) {
            PG8_LDB(B0, 0, 0); PG8_LDB(B1, 0, 1); PG8_SCHED; PG8_LDA(At, 0, 0); PG8_STAGE(PG8_SA(1, 1), a1 + hstep, voffA);
            PG8_WAIT_V(8); PG8_WAIT_L(0); PG8_BAR; PG8_MMA(0, 0, At, B0); PG8_MMA(0, 1, At, B1); PG8_BAR; PG8_SCHED;
            PG8_LDA(At, 0, 1); PG8_STAGE(PG8_SB(0, 0), b2, voffB); PG8_STAGE(PG8_SB(0, 1), b2 + hstep, voffB); PG8_STAGE(PG8_SA(0, 0), a2, voffA);
            PG8_WAIT_V(8); PG8_WAIT_L(0); PG8_BAR; PG8_MMA(1, 0, At, B0); PG8_MMA(1, 1, At, B1); PG8_BAR; PG8_SCHED;
            PG8_LDB(B0, 1, 0); PG8_LDB(B1, 1, 1); PG8_SCHED; PG8_LDA(At, 1, 0); PG8_STAGE(PG8_SA(0, 1), a2 + hstep, voffA);
            PG8_WAIT_V(8); PG8_WAIT_L(0); PG8_BAR; PG8_MMA(0, 0, At, B0); PG8_MMA(0, 1, At, B1); PG8_BAR; PG8_SCHED;
            PG8_LDA(At, 1, 1); PG8_STAGE(PG8_SB(1, 0), b3, voffB); PG8_STAGE(PG8_SB(1, 1), b3 + hstep, voffB); PG8_STAGE(PG8_SA(1, 0), a3, voffA);
            PG8_WAIT_V(8); PG8_WAIT_L(0); PG8_BAR; PG8_MMA(1, 0, At, B0); PG8_MMA(1, 1, At, B1); PG8_BAR; PG8_SCHED;
            } else {
            PG8_LDB(B0, 0, 0); PG8_SCHED; PG8_LDA(At, 0, 0); PG8_STAGE(PG8_SA(1, 1), a1 + hstep, voffA);
            PG8_WAIT_L(8); PG8_BAR; PG8_WAIT_L(0); PG8_MMA(0, 0, At, B0); PG8_BAR; PG8_SCHED;
            PG8_LDB(B1, 0, 1); PG8_STAGE(PG8_SB(0, 0), b2, voffB);
            PG8_BAR; PG8_WAIT_L(0); PG8_MMA(0, 1, At, B1); PG8_BAR;
            PG8_LDA(At, 0, 1); PG8_STAGE(PG8_SA(0, 0), a2, voffA);
            PG8_BAR; PG8_WAIT_L(0); PG8_MMA(1, 0, At, B0); PG8_BAR; PG8_SCHED;
            PG8_STAGE(PG8_SB(0, 1), b2 + hstep, voffB);
            PG8_WAIT_V(6); PG8_BAR; PG8_MMA(1, 1, At, B1); PG8_BAR;
            PG8_LDB(B0, 1, 0); PG8_SCHED; PG8_LDA(At, 1, 0); PG8_STAGE(PG8_SA(0, 1), a2 + hstep, voffA);
            PG8_WAIT_L(8); PG8_BAR; PG8_WAIT_L(0); PG8_MMA(0, 0, At, B0); PG8_BAR; PG8_SCHED;
            PG8_LDB(B1, 1, 1); PG8_STAGE(PG8_SB(1, 0), b3, voffB);
            PG8_BAR; PG8_WAIT_L(0); PG8_MMA(0, 1, At, B1); PG8_BAR;
            PG8_LDA(At, 1, 1); PG8_STAGE(PG8_SA(1, 0), a3, voffA);
            PG8_BAR; PG8_WAIT_L(0); PG8_MMA(1, 0, At, B0); PG8_BAR; PG8_SCHED;
            PG8_STAGE(PG8_SB(1, 1), b3 + hstep, voffB);
            PG8_WAIT_V(6); PG8_BAR; PG8_MMA(1, 1, At, B1); PG8_BAR;
            }
        }
        if constexpr (ALIGN_EPI) { if (wr == 0) PG8_BAR; }
        if constexpr (!Epi::AFTER_DRAIN) { E(acc, cur, wr, wc, fr, fq); S.done(cur); }
        if (!has_next) break;
#pragma unroll
        for (int a = 0; a < 2; ++a)
#pragma unroll
            for (int b = 0; b < 2; ++b)
#pragma unroll
                for (int m = 0; m < 4; ++m)
#pragma unroll
                    for (int n = 0; n < 2; ++n) acc[a][b][m][n] = (f32x4){0.f, 0.f, 0.f, 0.f};
        cur = nxt; cA = nA; cB = nB; ++ui;
        if constexpr (ALIGN_EPI) { if (wr == 1) PG8_BAR; }
    }
    PG8_WAIT_V(0);
    if constexpr (!ALIGN_EPI) { if (wr == 0) PG8_BAR; }
    PG8_BAR;
    if constexpr (Epi::AFTER_DRAIN) { E.fused(acc, cur, wr, wc, fr, fq, lds, wid, lane); S.done(cur); }
#undef PG8_SA
#undef PG8_SB
#undef PG8_STAGE
#undef PG8_LDA
#undef PG8_LDB
#undef PG8_MMA
#undef PG8_WAIT_V
#undef PG8_WAIT_L
#undef PG8_BAR
#undef PG8_SCHED
}
}

#include <hip/hip_cooperative_groups.h>
#include <cstdio>
#include <cstdint>
namespace cg = cooperative_groups;
#define GAS __attribute__((address_space(1)))
#define LAS __attribute__((address_space(3)))
typedef unsigned short bf16;
typedef unsigned v4u __attribute__((ext_vector_type(4)));
typedef unsigned v2u __attribute__((ext_vector_type(2)));
typedef float f32x4 __attribute__((ext_vector_type(4)));
typedef float f32x16 __attribute__((ext_vector_type(16)));
typedef short bf16x8 __attribute__((ext_vector_type(8)));
typedef short v4i16_t __attribute__((ext_vector_type(4)));
#define LDS_WAIT() asm volatile("s_waitcnt lgkmcnt(0)" ::: "memory")
__device__ __forceinline__ unsigned f2bf(float f) { unsigned u = __builtin_bit_cast(unsigned, f); return (u + 0x7fffu + ((u >> 16) & 1u)) >> 16; }
typedef float f32x2_t __attribute__((ext_vector_type(2))); typedef __bf16 bf16x2_t __attribute__((ext_vector_type(2)));
__device__ __forceinline__ unsigned pk2(float lo, float hi) { f32x2_t v = {lo, hi}; bf16x2_t b = __builtin_convertvector(v, bf16x2_t); return __builtin_bit_cast(unsigned, b); }
__device__ __forceinline__ float bflo(unsigned w) { return __builtin_bit_cast(float, w << 16); }
__device__ __forceinline__ float bfhi(unsigned w) { return __builtin_bit_cast(float, w & 0xffff0000u); }
__device__ __forceinline__ float bf1(unsigned short s) { return __builtin_bit_cast(float, (unsigned)s << 16); }

constexpr int DM = 1024, SEQ = 4096, NB = 8, DB = 32, DS = 64, PAST = 1024;
constexpr int MP = NB * SEQ, MS = DB * DS, M = MP + MS;
constexpr int IN_AB = 2592, IN_ABP = 2816, IN_C = 3072, FF = 4096, QL = 768, KVL = 256;
constexpr int MKV = M + DB * PAST;
constexpr float ALPHA = 1.4142135623730951f;
constexpr float LOG2E = 1.4426950408889634f;

constexpr size_t O_Y = 0, O_CKVP = 35651584, O_KRP = 44040192, O_BKP = 45088768, O_BVP = 47185920, O_SKP = 49283072, O_SVP = 82837504,
                 O_CKVS = 116391936, O_KRS = 116916224, O_BKS = 116981760, O_BVS = 125370368, O_SKS = 133758976, O_SVS = 135856128, O_END = 137953280;
constexpr size_t W_INAB = 1u << 20, W_UQ = W_INAB + (size_t)IN_ABP * DM * 2, W_UKV = W_UQ + (size_t)768 * 768 * 2, W_OUTAB = W_UKV + (size_t)1024 * 256 * 2,
                 W_INC = W_OUTAB + (size_t)DM * DM * 2, W_OUTC = W_INC + (size_t)IN_C * DM * 2, W_UP = W_OUTC + (size_t)DM * DM * 2, W_DOWN = W_UP + (size_t)2 * FF * DM * 2,
                 W_ROPE = W_DOWN + (size_t)2 * FF * DM * 2, W_XB = W_ROPE + (size_t)SEQ * 32 * 4, W_H = W_XB + (size_t)M * DM * 2, W_KV = W_H + (size_t)M * IN_C * 2,
                 W_END = W_KV + (size_t)MKV * 1024 * 2;
constexpr size_t W_PART = W_END, W_XH = W_PART + (size_t)8 * MS * DM * 4, W_END2 = W_XH + (size_t)M * DM * 2;
static_assert((size_t)M * FF * 2 <= W_END - W_H, "U overlay");
static_assert((size_t)2 * DB * PAST * 1024 * 2 <= W_END - W_KV, "csb overlay");
constexpr size_t S_QL = O_SKP * 4, S_QA = S_QL + (size_t)M * 768 * 2;
constexpr size_t S_CKV = O_SVP * 4, S_KR = S_CKV + (size_t)MKV * 256 * 2, S_CBK = S_KR + (size_t)MKV * 32 * 2, S_CBV = S_CBK + (size_t)DB * 512 * 512 * 2, S_END2 = S_CBV + (size_t)DB * 512 * 512 * 2;
static_assert(S_QA + (size_t)M * 768 * 2 <= O_SVP * 4 && S_END2 <= O_CKVS * 4, "d_out scratch");

constexpr int LDS_BYTES = 147456;

struct Args {
    const float* in[23]; float* out; unsigned char* ws; int ph_lo, ph_hi;
};

#define dpp_add(v, old, ctrl, rmask) __builtin_bit_cast(float, __builtin_amdgcn_update_dpp(__builtin_bit_cast(int, (float)(old)), __builtin_bit_cast(int, (float)(v)), (ctrl), (rmask), 0xF, false))
__device__ __forceinline__ float wave_sum(float v) {
    v += dpp_add(v, 0.f, 0xB1, 0xF);
    v += dpp_add(v, 0.f, 0x4E, 0xF);
    v += dpp_add(v, 0.f, 0x141, 0xF);
    v += dpp_add(v, 0.f, 0x140, 0xF);
    v += dpp_add(v, 0.f, 0x142, 0xA);
    v += dpp_add(v, 0.f, 0x143, 0xC);
    return __builtin_bit_cast(float, __builtin_amdgcn_readlane(__builtin_bit_cast(int, v), 63));
}
__device__ __forceinline__ void transpose_item(const float* W, int K, int N, bf16* WT, LAS float* scr, int item, int lane, float sc0 = 1.f, int nlim = 1 << 30) {
    const int nblk = N / 32, kb = item / nblk, nb = item % nblk, k0 = 64 * kb, n0 = 32 * nb; const float sc = n0 < nlim ? sc0 : 1.f;
#pragma unroll 8
    for (int i = 0; i < 32; ++i) { const int kk = 2 * i + (lane >> 5); scr[kk * 33 + (lane & 31)] = W[(size_t)(k0 + kk) * N + n0 + (lane & 31)] * sc; }
    LDS_WAIT(); asm volatile("" ::: "memory");
    const int c = lane & 7;
#pragma unroll
    for (int j = 0; j < 4; ++j) { const int n = (lane >> 3) + 8 * j; const LAS float* s = scr + (8 * c) * 33 + n;
        v4u o; o.x = pk2(s[0 * 33], s[1 * 33]); o.y = pk2(s[2 * 33], s[3 * 33]); o.z = pk2(s[4 * 33], s[5 * 33]); o.w = pk2(s[6 * 33], s[7 * 33]);
        *(v4u*)(WT + (size_t)(n0 + n) * K + k0 + 8 * c) = o; }
    LDS_WAIT(); asm volatile("" ::: "memory");
}
__device__ __forceinline__ void cvt_rows(const float* src, bf16* dst, size_t n8, size_t gt, size_t gn) {
    for (size_t i = gt; i < n8; i += gn) { const f32x4 a = *(const f32x4*)(src + i * 8), b = *(const f32x4*)(src + i * 8 + 4);
        v4u o; o.x = pk2(a[0], a[1]); o.y = pk2(a[2], a[3]); o.z = pk2(b[0], b[1]); o.w = pk2(b[2], b[3]); *(v4u*)(dst + i * 8) = o; }
}

namespace att {
constexpr int VSTR = 192, KB_MAX = 64 * 208, VB = 64 * VSTR, BUFSZ = KB_MAX + VB, BIAS_OFF = 2 * BUFSZ;
struct AU {
    const bf16* q; int qp;
    const bf16 *kA, *vA, *rA; int pA;
    const bf16 *kB, *vB, *rB; int pB;
    const float *kAf, *vAf;
    bf16* o; int op;
    int ntA, nrows, qpos0, h;
};
__device__ __forceinline__ float halves_max(float m) { auto rr = __builtin_amdgcn_permlane32_swap(__float_as_uint(m), __float_as_uint(m), false, false); return fmaxf(__uint_as_float(rr[0]), __uint_as_float(rr[1])); }
__device__ __forceinline__ float halves_sum(float m) { auto rr = __builtin_amdgcn_permlane32_swap(__float_as_uint(m), __float_as_uint(m), false, false); return __uint_as_float(rr[0]) + __uint_as_float(rr[1]); }
__device__ __forceinline__ float partner(float m, int hi) { auto rr = __builtin_amdgcn_permlane32_swap(__float_as_uint(m), __float_as_uint(m), false, false); return hi ? __uint_as_float(rr[0]) : __uint_as_float(rr[1]); }
__device__ __forceinline__ int crow(int r, int hi) { return (r & 3) + 8 * (r >> 2) + 4 * hi; }
#define MFMA32(a, b, c) __builtin_amdgcn_mfma_f32_32x32x16_bf16((a), (b), (c), 0, 0, 0)

struct TL { unsigned long long a[3], b[3]; int sa[3], sb[3], ld[3], c[3]; };
template <int MODE> __device__ __forceinline__ void tile_ctx(const AU& U, int tid, TL& C) {
    constexpr int CPR = MODE == 0 ? 20 : 16, NCH = 64 * CPR, NLD = (NCH + 511) / 512, KC = MODE == 0 ? 12 : 8, KSTR = MODE == 0 ? 208 : 144;
#pragma unroll
    for (int i = 0; i < NLD; ++i) { const int c0 = tid + 512 * i; const int c = c0 < NCH ? c0 : c0 - 512;
        const int row = c / CPR, cc = c % CPR; C.c[i] = c;
        const bool isk = cc < 8, isr = (MODE == 0) && cc >= 8 && cc < 12; const int vo = cc - (MODE == 0 ? 12 : 8);
        const unsigned long long kAa = (unsigned long long)U.kA, vAa = (unsigned long long)U.vA, rAa = (unsigned long long)U.rA, kBa = (unsigned long long)U.kB, vBa = (unsigned long long)U.vB, rBa = (unsigned long long)U.rB;
        const unsigned long long offA = isr ? (unsigned long long)(row * 32 + (cc - 8) * 8) * 2ull : ((unsigned long long)row * (unsigned long long)U.pA + (unsigned long long)((isk ? cc : vo) * 8)) * 2ull;
        const unsigned long long offB = isr ? (unsigned long long)(row * 32 + (cc - 8) * 8) * 2ull : ((unsigned long long)row * (unsigned long long)U.pB + (unsigned long long)((isk ? cc : vo) * 8)) * 2ull;
        C.a[i] = (isk ? kAa : (isr ? rAa : vAa)) + offA; C.b[i] = (isk ? kBa : (isr ? rBa : vBa)) + offB;
        C.sa[i] = (isr ? 64 * 32 : 64 * U.pA) * 2; C.sb[i] = (isr ? 64 * 32 : 64 * U.pB) * 2;
        C.ld[i] = cc < KC ? row * KSTR + cc * 16 : KB_MAX + row * VSTR + (cc - KC) * 16; }
}
template <int MODE> __device__ __forceinline__ void tile_loads(const AU& U, const TL& C, int T, v4u (&pre)[3]) {
    constexpr int CPR = MODE == 0 ? 20 : 16, NCH = 64 * CPR, NLD = (NCH + 511) / 512;
    const bool useA = T < U.ntA;
    if (MODE != 0 && useA && U.kAf) {
#pragma unroll
        for (int i = 0; i < NLD; ++i) { const int row = C.c[i] / CPR, cc = C.c[i] % CPR;
            const float* fs = cc < 8 ? U.kAf + (size_t)(T * 64 + row) * U.pA + cc * 8 : U.vAf + (size_t)(T * 64 + row) * U.pA + (cc - 8) * 8;
            const f32x4 a = *(const f32x4*)fs, b = *(const f32x4*)(fs + 4); v4u o; o.x = pk2(a[0], a[1]); o.y = pk2(a[2], a[3]); o.z = pk2(b[0], b[1]); o.w = pk2(b[2], b[3]); pre[i] = o; }
    } else {
        const int tt = useA ? T : T - U.ntA;
#pragma unroll
        for (int i = 0; i < NLD; ++i) { const unsigned long long src = useA ? C.a[i] + (unsigned long long)tt * (unsigned long long)C.sa[i] : C.b[i] + (unsigned long long)tt * (unsigned long long)C.sb[i]; pre[i] = *(const GAS v4u*)src; }
    }
}
template <int MODE> __device__ __forceinline__ void tile_stores(LAS unsigned char* buf, const TL& C, const v4u (&pre)[3]) {
    constexpr int NLD = ((MODE == 0 ? 20 : 16) * 64 + 511) / 512;
#pragma unroll
    for (int i = 0; i < NLD; ++i) *(LAS v4u*)(buf + C.ld[i]) = pre[i];
}

template <int MODE> __device__ __forceinline__ void st_qk(const LAS unsigned char* buf, int r, int hi, const bf16x8 (&qf)[MODE == 0 ? 6 : 4], const f32x16& negm, f32x16& s0, f32x16& s1) {
    constexpr int NS = MODE == 0 ? 6 : 4, KSTR = MODE == 0 ? 208 : 144;
    const LAS unsigned char* kb = buf + r * KSTR + hi * 16;
#pragma unroll
    for (int s = 0; s < NS; ++s) { const bf16x8 a0 = *(const LAS bf16x8*)(kb + 32 * s), a1 = *(const LAS bf16x8*)(kb + 32 * KSTR + 32 * s);
        if (s == 0) { s0 = MFMA32(a0, qf[0], negm); s1 = MFMA32(a1, qf[0], negm); }
        else { s0 = MFMA32(a0, qf[s], s0); s1 = MFMA32(a1, qf[s], s1); } }
}
template <int MODE> __device__ __forceinline__ void st_sm(int T, int tq, int qpos, int hi, const LAS float* biasl, f32x16& s0, f32x16& s1, f32x16& o0, f32x16& o1, f32x16& negm, float& lrun, bool& fresh) {
    const float c2 = 0.125f * LOG2E;
    if (MODE == 1) {
        if (T + 5 <= tq) { const float cb = biasl[0];
#pragma unroll
            for (int i = 0; i < 16; ++i) { s0[i] = s0[i] * c2 + cb; s1[i] = s1[i] * c2 + cb; } }
        else if (T + 3 >= tq) { const volatile LAS float* bp = biasl + (256 - qpos + T * 64 + 4 * hi);
#pragma unroll
            for (int i = 0; i < 16; ++i) { s0[i] = s0[i] * c2 + bp[(i & 3) + 8 * (i >> 2)]; s1[i] = s1[i] * c2 + bp[(i & 3) + 8 * (i >> 2) + 32]; } }
        else {
#pragma unroll
            for (int i = 0; i < 16; ++i) { const int d0 = qpos - (T * 64 + crow(i, hi)); const int i0 = 256 - min(max(d0, -63), 256), i1 = 256 - min(max(d0 - 32, -63), 256);
                s0[i] = s0[i] * c2 + biasl[i0]; s1[i] = s1[i] * c2 + biasl[i1]; } }
    }
#define MX3_(a, b, c) __builtin_fmaxf(__builtin_fmaxf((a), (b)), (c))
    float ma = MX3_(s0[0], s0[1], s1[0]), mb = MX3_(s0[2], s0[3], s1[1]); ma = MX3_(ma, s1[2], s1[3]);
#pragma unroll
    for (int i = 4; i < 16; i += 4) { ma = MX3_(ma, s0[i], s0[i + 1]); mb = MX3_(mb, s0[i + 2], s0[i + 3]); ma = MX3_(ma, s1[i], s1[i + 1]); mb = MX3_(mb, s1[i + 2], s1[i + 3]); }
#undef MX3_
    float mx = halves_max(__builtin_fmaxf(ma, mb));
    if (fresh || __any(mx > 6.0f)) {
        const float dl = fresh ? mx : fmaxf(mx, 0.f), al = __builtin_amdgcn_exp2f(-dl); lrun *= al; fresh = false;
        const float dn = (MODE == 0) ? dl : dl * (8.0f / LOG2E);
#pragma unroll
        for (int i = 0; i < 16; ++i) { s0[i] -= dl; s1[i] -= dl; o0[i] *= al; o1[i] *= al; negm[i] -= dn; } }
    float sum = 0.f;
#pragma unroll
    for (int i = 0; i < 16; ++i) { s0[i] = __builtin_amdgcn_exp2f(s0[i]); s1[i] = __builtin_amdgcn_exp2f(s1[i]); sum += s0[i] + s1[i]; }
    lrun += sum;
}
__device__ __forceinline__ void st_vread(const LAS unsigned char* buf, int vlane, bf16x8 (&vf)[8]) {
    const LAS unsigned char* vb = buf + KB_MAX + vlane;
#pragma unroll
    for (int ks = 0; ks < 4; ++ks) {
#pragma unroll
        for (int db = 0; db < 2; ++db) {
            const v4i16_t lo = __builtin_amdgcn_ds_read_tr16_b64_v4i16((LAS v4i16_t*)(vb + (16 * ks) * VSTR + db * 64));
            const v4i16_t hh = __builtin_amdgcn_ds_read_tr16_b64_v4i16((LAS v4i16_t*)(vb + (16 * ks + 8) * VSTR + db * 64));
            vf[2 * ks + db] = (bf16x8){lo[0], lo[1], lo[2], lo[3], hh[0], hh[1], hh[2], hh[3]}; } }
}
__device__ __forceinline__ void st_pv(const bf16x8 (&vf)[8], const f32x16& s0, const f32x16& s1, f32x16& o0, f32x16& o1) {
    bf16x8 pf[4];
#pragma unroll
    for (int s = 0; s < 2; ++s) {
        v4u a, b;
        a.x = pk2(s0[8 * s], s0[8 * s + 1]); a.y = pk2(s0[8 * s + 2], s0[8 * s + 3]); a.z = pk2(s0[8 * s + 4], s0[8 * s + 5]); a.w = pk2(s0[8 * s + 6], s0[8 * s + 7]);
        b.x = pk2(s1[8 * s], s1[8 * s + 1]); b.y = pk2(s1[8 * s + 2], s1[8 * s + 3]); b.z = pk2(s1[8 * s + 4], s1[8 * s + 5]); b.w = pk2(s1[8 * s + 6], s1[8 * s + 7]);
        pf[s] = __builtin_bit_cast(bf16x8, a); pf[2 + s] = __builtin_bit_cast(bf16x8, b); }
#pragma unroll
    for (int ks = 0; ks < 4; ++ks) { o0 = MFMA32(vf[2 * ks], pf[ks], o0); o1 = MFMA32(vf[2 * ks + 1], pf[ks], o1); }
}
template <int MODE> __device__ __forceinline__ void attn_unit(const AU& U, LAS unsigned char* lds, const float* rope, const float* biasg) {
    constexpr int NS = MODE == 0 ? 6 : 4;
    int tid = threadIdx.x; asm volatile("" : "+v"(tid));
    const int lane = tid & 63, r = lane & 31, hi = lane >> 5, w = __builtin_amdgcn_readfirstlane(tid >> 6);
    const bool active = 32 * w < U.nrows;
    const int tq = (U.qpos0 + 32 * w) >> 6;
    const int wlo = MODE == 1 ? (tq > 8 ? tq - 8 : 0) : 0, whi = tq;
    const int g0 = U.qpos0 >> 6;
    const int glo = MODE == 1 ? (g0 > 8 ? g0 - 8 : 0) : 0, ghi = (U.qpos0 + U.nrows - 1) >> 6;
    const int qpos = U.qpos0 + 32 * w + r;
    LAS float* biasl = (LAS float*)(lds + BIAS_OFF);
    if (MODE == 1) { for (int i = tid; i < 320; i += 512) biasl[i] = biasg[U.h * 320 + 319 - i] * LOG2E; }
    bf16x8 qf[NS];
    if (active) { const bf16* qrow = U.q + (size_t)(32 * w + r) * U.qp;
#pragma unroll
        for (int s = 0; s < NS; ++s) qf[s] = *(const bf16x8*)(qrow + 16 * s + 8 * hi);
        if (MODE == 0) { const float* rp = rope + (size_t)qpos * 32 + 16 * hi;
#pragma unroll
            for (int j = 0; j < 8; ++j) { const float cs = rp[2 * j], sn = rp[2 * j + 1]; const float x1 = bf1((unsigned short)qf[4][j]), x2 = bf1((unsigned short)qf[5][j]);
                qf[4][j] = (short)f2bf(x1 * cs - x2 * sn); qf[5][j] = (short)f2bf(x2 * cs + x1 * sn); } }
    } else {
#pragma unroll
        for (int s = 0; s < NS; ++s) qf[s] = (bf16x8){0, 0, 0, 0, 0, 0, 0, 0};
    }
    f32x16 o0, o1;
#pragma unroll
    for (int i = 0; i < 16; ++i) { o0[i] = 0.f; o1[i] = 0.f; }
    float lrun = 0.f; bool fresh = true; f32x16 negm;
#pragma unroll
    for (int i = 0; i < 16; ++i) negm[i] = 0.f;
    v4u preA[3], preB[3]; TL C; tile_ctx<MODE>(U, tid, C);
    tile_loads<MODE>(U, C, glo, preA); tile_stores<MODE>(lds, C, preA);
    tile_loads<MODE>(U, C, (glo < ghi ? glo + 1 : ghi), preA);
    __syncthreads();
    int cur = 0;
    const int vlane = (4 * hi + ((lane & 15) >> 2)) * VSTR + ((lane >> 4) & 1) * 32 + (lane & 3) * 8;
#define ATT_ITER(PX, PY) { \
        const bool has_next = T < ghi; \
        tile_loads<MODE>(U, C, (T + 2 < ghi ? T + 2 : ghi), PY);     \
        const LAS unsigned char* buf = lds + cur * BUFSZ; \
        if (active && T >= wlo && T <= whi) { f32x16 s0, s1; bf16x8 vf[8]; st_qk<MODE>(buf, r, hi, qf, negm, s0, s1); st_vread(buf, vlane, vf); st_sm<MODE>(T, tq, qpos, hi, biasl, s0, s1, o0, o1, negm, lrun, fresh); st_pv(vf, s0, s1, o0, o1); } \
        if (has_next) tile_stores<MODE>(lds + (cur ^ 1) * BUFSZ, C, PX); \
        asm volatile("s_waitcnt lgkmcnt(0)" ::: "memory"); __builtin_amdgcn_s_barrier(); asm volatile("" ::: "memory"); \
        if (!has_next) break; \
        cur ^= 1; ++T; }
    for (int T = glo;;) { ATT_ITER(preA, preB); ATT_ITER(preB, preA); }
#undef ATT_ITER
    if (active) {
        const float inv = 1.f / halves_sum(lrun);
        bf16* orow = U.o + (size_t)(32 * w + r) * U.op + 4 * hi;
#pragma unroll
        for (int g = 0; g < 4; ++g) {
            v2u a, b; a.x = pk2(o0[4 * g] * inv, o0[4 * g + 1] * inv); a.y = pk2(o0[4 * g + 2] * inv, o0[4 * g + 3] * inv);
            b.x = pk2(o1[4 * g] * inv, o1[4 * g + 1] * inv); b.y = pk2(o1[4 * g + 2] * inv, o1[4 * g + 3] * inv);
            *(v2u*)(orow + 8 * g) = a; *(v2u*)(orow + 32 + 8 * g) = b; }
    }
    __syncthreads();
}
}


constexpr int SB_HB = 2 * 64 * 144;
template <bool SMP> __device__ __forceinline__ void sb_loads(const bf16* Hb, const float* c_sk, const float* c_sv, int b, int c, int hg, int T, int tid, v4u (&pre)[8]) {
    const bool f32src = SMP && T < 16;
    if (!f32src) { const size_t srow0 = SMP ? (size_t)MP + b * 64 : (size_t)b * SEQ + (size_t)T * 64;
#pragma unroll
        for (int i = 0; i < 8; ++i) { const int ch = tid + 512 * i, row = ch >> 6, cc = ch & 63;
            pre[i] = *(const v4u*)(Hb + (srow0 + row) * IN_C + (cc >= 32 ? 2048 : 1024) + hg * 256 + (cc & 31) * 8); } }
    else {
#pragma unroll
        for (int hf = 0; hf < 2; ++hf) {
#pragma unroll
            for (int i2 = 0; i2 < 4; ++i2) { const int i = hf * 4 + i2; const int ch = tid + 512 * i, row = ch >> 6, cc = ch & 63;
                const float* fs = (cc >= 32 ? c_sv : c_sk) + ((size_t)b * PAST + (size_t)T * 64 + row) * 1024 + hg * 256 + (cc & 31) * 8;
                const f32x4 a = *(const f32x4*)fs, bq = *(const f32x4*)(fs + 4); v4u o; o.x = pk2(a[0], a[1]); o.y = pk2(a[2], a[3]); o.z = pk2(bq[0], bq[1]); o.w = pk2(bq[2], bq[3]); pre[i] = o; }
            asm volatile("" ::: "memory"); } }
}
__device__ __forceinline__ void sb_stores(LAS unsigned char* lds, int tid, const v4u (&pre)[8]) {
#pragma unroll
    for (int i = 0; i < 8; ++i) { const int ch = tid + 512 * i, row = ch >> 6, cc = ch & 63;
        *(LAS v4u*)(lds + ((cc & 31) >> 3) * SB_HB + (cc >= 32 ? 9216 : 0) + row * 144 + (cc & 7) * 16) = pre[i]; }
}
template <bool SMP> __device__ __forceinline__ void sb_unit4(const bf16* Hb, const float* c_sk, const float* c_sv, bf16* O, int b, int c, int hg, LAS unsigned char* lds) {
    using namespace att;
    int tid = threadIdx.x; asm volatile("" : "+v"(tid));
    const int lane = tid & 63, r = lane & 31, hi = lane >> 5, w = __builtin_amdgcn_readfirstlane(tid >> 6), hw = w >> 1, half = w & 1;
    const int tq = SMP ? 16 : c;
    const size_t qrow = (SMP ? (size_t)MP + b * 64 : (size_t)b * SEQ + (size_t)c * 64) + 32 * half + r;
    const int qpos = tq * 64 + 32 * half + r;
    bf16x8 qf[4];
#pragma unroll
    for (int s = 0; s < 4; ++s) qf[s] = *(const bf16x8*)(Hb + qrow * IN_C + (hg * 4 + hw) * 64 + 16 * s + 8 * hi);
    f32x16 o0, o1;
#pragma unroll
    for (int i = 0; i < 16; ++i) { o0[i] = 0.f; o1[i] = 0.f; }
    float carry = 1.f;
    v4u pre[8];
    sb_loads<SMP>(Hb, c_sk, c_sv, b, c, hg, tq, tid, pre);
    LAS unsigned char* hb = lds + hw * SB_HB;
    const int vlane = (4 * hi + ((lane & 15) >> 2)) * 144 + ((lane >> 4) & 1) * 32 + (lane & 3) * 8;
    for (int T = tq;; --T) {
        sb_stores(lds, tid, pre);
        __syncthreads();
        const bool has_next = T > 0;
        if (has_next) sb_loads<SMP>(Hb, c_sk, c_sv, b, c, hg, T - 1, tid, pre);
        {
            const LAS unsigned char* kb = hb + r * 144 + hi * 16;
            f32x16 s0, s1; const f32x16 zero16 = {0.f, 0.f, 0.f, 0.f, 0.f, 0.f, 0.f, 0.f, 0.f, 0.f, 0.f, 0.f, 0.f, 0.f, 0.f, 0.f};
#pragma unroll
            for (int s = 0; s < 4; ++s) { const bf16x8 a0 = *(const LAS bf16x8*)(kb + 32 * s), a1 = *(const LAS bf16x8*)(kb + 32 * 144 + 32 * s);
                if (s == 0) { s0 = MFMA32(a0, qf[0], zero16); s1 = MFMA32(a1, qf[0], zero16); } else { s0 = MFMA32(a0, qf[s], s0); s1 = MFMA32(a1, qf[s], s1); } }
            bf16x8 vf[8];
            { const LAS unsigned char* vb = hb + 9216 + vlane;
#pragma unroll
              for (int ks = 0; ks < 4; ++ks) {
#pragma unroll
                for (int db = 0; db < 2; ++db) {
                    const v4i16_t lo = __builtin_amdgcn_ds_read_tr16_b64_v4i16((LAS v4i16_t*)(vb + (16 * ks) * 144 + db * 64));
                    const v4i16_t hh = __builtin_amdgcn_ds_read_tr16_b64_v4i16((LAS v4i16_t*)(vb + (16 * ks + 8) * 144 + db * 64));
                    vf[2 * ks + db] = (bf16x8){lo[0], lo[1], lo[2], lo[3], hh[0], hh[1], hh[2], hh[3]}; } } }
            f32x16 U0, U1;
#pragma unroll
            for (int i = 0; i < 16; ++i) {
                const float e0 = __builtin_amdgcn_exp2f(s0[i]), e1 = __builtin_amdgcn_exp2f(s1[i]);
                U0[i] = __builtin_amdgcn_rcpf(1.f + e0); U1[i] = __builtin_amdgcn_rcpf(1.f + e1);
                s0[i] = 1.f - U0[i]; s1[i] = 1.f - U1[i]; }
            if (T == tq) {
#pragma unroll
                for (int i = 0; i < 16; ++i) { const int kv = T * 64 + crow(i, hi);
                    if (kv >= qpos) { U0[i] = 1.f; s0[i] = 0.f; } if (kv + 32 >= qpos) { U1[i] = 1.f; s1[i] = 0.f; } } }
            float R = carry;
#pragma unroll
            for (int bg = 7; bg >= 0; --bg) { const int g = bg & 3;
                if (bg >= 4) { const float gs = (U1[4 * g] * U1[4 * g + 1]) * (U1[4 * g + 2] * U1[4 * g + 3]); const float gp = partner(gs, hi);
                    const float t3 = hi ? R : R * gp, t2 = t3 * U1[4 * g + 3], t1 = t2 * U1[4 * g + 2], t0 = t1 * U1[4 * g + 1];
                    s1[4 * g + 3] *= t3; s1[4 * g + 2] *= t2; s1[4 * g + 1] *= t1; s1[4 * g] *= t0; R *= gs * gp; }
                else { const float gs = (U0[4 * g] * U0[4 * g + 1]) * (U0[4 * g + 2] * U0[4 * g + 3]); const float gp = partner(gs, hi);
                    const float t3 = hi ? R : R * gp, t2 = t3 * U0[4 * g + 3], t1 = t2 * U0[4 * g + 2], t0 = t1 * U0[4 * g + 1];
                    s0[4 * g + 3] *= t3; s0[4 * g + 2] *= t2; s0[4 * g + 1] *= t1; s0[4 * g] *= t0; R *= gs * gp; }
            }
            carry = R;
            bf16x8 pf[4];
#pragma unroll
            for (int s = 0; s < 2; ++s) {
                v4u a, bq;
                a.x = pk2(s0[8 * s], s0[8 * s + 1]); a.y = pk2(s0[8 * s + 2], s0[8 * s + 3]); a.z = pk2(s0[8 * s + 4], s0[8 * s + 5]); a.w = pk2(s0[8 * s + 6], s0[8 * s + 7]);
                bq.x = pk2(s1[8 * s], s1[8 * s + 1]); bq.y = pk2(s1[8 * s + 2], s1[8 * s + 3]); bq.z = pk2(s1[8 * s + 4], s1[8 * s + 5]); bq.w = pk2(s1[8 * s + 6], s1[8 * s + 7]);
                pf[s] = __builtin_bit_cast(bf16x8, a); pf[2 + s] = __builtin_bit_cast(bf16x8, bq); }
#pragma unroll
            for (int ks = 0; ks < 4; ++ks) { o0 = MFMA32(vf[2 * ks], pf[ks], o0); o1 = MFMA32(vf[2 * ks + 1], pf[ks], o1); }
        }
        const int done = __all(carry == 0.f);
        if (__syncthreads_and(done) || !has_next) break;
    }
    bf16* orow = O + qrow * 1024 + (hg * 4 + hw) * 64 + 4 * hi;
#pragma unroll
    for (int g = 0; g < 4; ++g) {
        v2u a, bq; a.x = pk2(o0[4 * g], o0[4 * g + 1]); a.y = pk2(o0[4 * g + 2], o0[4 * g + 3]);
        bq.x = pk2(o1[4 * g], o1[4 * g + 1]); bq.y = pk2(o1[4 * g + 2], o1[4 * g + 3]);
        *(v2u*)(orow + 8 * g) = a; *(v2u*)(orow + 32 + 8 * g) = bq; }
    __syncthreads();
}

#define XB_TMO      128
#define XB_XCNT(j)  (256  + 64 * (j))
#define XB_XSUB(j)  (1280 + 64 * (j))
#define XB_XGEN(j)  (2304 + 64 * (j))
#define XB_TOP      3328
#define XB_TOPGEN   3392
#define XCD_BAR_WORDS 3456
#define XB_SPIN_CAP (1u << 18)

__device__ __forceinline__ unsigned xb_ld(unsigned* p)              { return __hip_atomic_load(p, __ATOMIC_RELAXED, __HIP_MEMORY_SCOPE_AGENT); }
__device__ __forceinline__ unsigned xb_add(unsigned* p, unsigned v) { return __hip_atomic_fetch_add(p, v, __ATOMIC_RELAXED, __HIP_MEMORY_SCOPE_AGENT); }
__device__ __forceinline__ unsigned xb_xcc_id() { return (unsigned)__builtin_amdgcn_s_getreg((3 << 11) | 20) & 0xFu; }
#define XB_SPIN(cond, bar) do { unsigned _sp = 0; while (cond) { __builtin_amdgcn_s_sleep(1); \
    if ((++_sp & 255u) == 0u) { if (xb_ld(&(bar)[XB_TMO])) break; if (_sp > XB_SPIN_CAP) { atomicAdd(&(bar)[XB_TMO], 1u); break; } } } } while (0)

struct XcdBarrier {
    unsigned* bar; unsigned x;
    volatile LAS unsigned* st;
};

__device__ __forceinline__ XcdBarrier xcd_barrier_post(unsigned* bar, volatile LAS unsigned* st) {
    XcdBarrier b; b.bar = bar; b.x = xb_xcc_id(); b.st = st;
    if (threadIdx.x == 0) (void)xb_add(&bar[XB_XCNT(b.x)], 1u);
    return b;
}
__device__ __forceinline__ void xcd_barrier_complete(unsigned* bar, unsigned x, unsigned& nloc, unsigned& nx) {
    const unsigned G = gridDim.x * gridDim.y * gridDim.z;
    unsigned sum, cnt, mine, sp = 0u;
    for (;;) {
        sum = 0u; cnt = 0u; mine = 0u;
#pragma unroll
        for (unsigned j = 0; j < 16; ++j) { const unsigned c = xb_ld(&bar[XB_XCNT(j)]); sum += c; cnt += (c > 0u) ? 1u : 0u; mine = (j == x) ? c : mine; }
        if (sum == G) break;
        __builtin_amdgcn_s_sleep(1);
        if ((++sp & 255u) == 0u) { if (xb_ld(&bar[XB_TMO])) break; if (sp > XB_SPIN_CAP) { atomicAdd(&bar[XB_TMO], 1u); break; } }
    }
    nloc = mine > 0u ? mine : 1u; nx = cnt > 0u ? cnt : 1u;
}

__device__ __forceinline__ void xcd_barrier(const XcdBarrier& b) {
    asm volatile("s_waitcnt vmcnt(0)" ::: "memory");
    __syncthreads();
    if (threadIdx.x == 0) {
        unsigned* bar = b.bar;
        __builtin_amdgcn_s_waitcnt(0);
        unsigned nloc = b.st[0], nx = b.st[1];
        if (nloc == 0u) { xcd_barrier_complete(bar, b.x, nloc, nx); b.st[0] = nloc; b.st[1] = nx; }
        const unsigned old = xb_add(&bar[XB_XSUB(b.x)], 1u);
        const unsigned gen = old / nloc;
        if (old + 1u == (gen + 1u) * nloc) {
            __builtin_amdgcn_fence(__ATOMIC_RELEASE, "agent");
            asm volatile("s_waitcnt vmcnt(0)" ::: "memory");
            const unsigned og = xb_add(&bar[XB_TOP], 1u);
            const unsigned tg = og / nx;
            if (og + 1u == (tg + 1u) * nx) xb_add(&bar[XB_TOPGEN], 1u);
            else XB_SPIN(xb_ld(&bar[XB_TOPGEN]) == tg, bar);
            __builtin_amdgcn_fence(__ATOMIC_ACQUIRE, "agent");
            xb_add(&bar[XB_XGEN(b.x)], 1u);
            asm volatile("s_waitcnt vmcnt(0)" ::: "memory");
        } else {
            XB_SPIN(xb_ld(&bar[XB_XGEN(b.x)]) == gen, bar);
            __builtin_amdgcn_fence(__ATOMIC_ACQUIRE, "agent");
            asm volatile("s_waitcnt vmcnt(0)" ::: "memory");
        }
    }
    __syncthreads();
}

#ifndef PROBE_P4
#define PROBE_P4 1
#endif
#ifndef PROBE_P11
#define PROBE_P11 1
#endif
#ifndef PROBE_SYNC
#define PROBE_SYNC 1
#endif
constexpr int NPH = 17;
__global__ void __launch_bounds__(512, 2) fwd(Args args) {
    extern __shared__ __attribute__((aligned(16))) unsigned char lds_raw[];
    LAS unsigned char* lds = (LAS unsigned char*)lds_raw;
    const int tid = threadIdx.x, lane = tid & 63, wave = __builtin_amdgcn_readfirstlane(tid >> 6);
    const int G = gridDim.x, bx = blockIdx.x;
    const int gw = bx * 8 + wave, NGW = G * 8;
    const size_t gt = (size_t)bx * 512 + tid, gn = (size_t)G * 512;
    unsigned char* ws = args.ws; float* out = args.out;
    const float *x_p = args.in[0], *x_s = args.in[1], *c_ckv = args.in[2], *c_kr = args.in[3], *c_bk = args.in[4], *c_bv = args.in[5], *c_sk = args.in[6], *c_sv = args.in[7];
    const float *w_in_ab = args.in[8], *g_q = args.in[9], *w_uq = args.in[10], *g_kv = args.in[11], *w_ukv = args.in[12], *rel_bias = args.in[13], *w_out_ab = args.in[14];
    const float *w_in_c = args.in[15], *w_out_c = args.in[16], *ln_mix_g = args.in[17], *ln_mix_b = args.in[18], *ln_ffn_g = args.in[19], *ln_ffn_b = args.in[20], *w_up = args.in[21], *w_down = args.in[22];
    bf16 *Wt_inab = (bf16*)(ws + W_INAB), *Wt_uq = (bf16*)(ws + W_UQ), *Wt_ukv = (bf16*)(ws + W_UKV), *Wt_outab = (bf16*)(ws + W_OUTAB), *Wt_inc = (bf16*)(ws + W_INC), *Wt_outc = (bf16*)(ws + W_OUTC);
    bf16 *Wt_up = (bf16*)(ws + W_UP), *Wt_down = (bf16*)(ws + W_DOWN);
    float* rope = (float*)(ws + W_ROPE);
    bf16 *Xb = (bf16*)(ws + W_XB), *Hb = (bf16*)(ws + W_H), *KVb = (bf16*)(ws + W_KV), *Ub = (bf16*)(ws + W_H), *Ob = Xb;
    unsigned char* ob = (unsigned char*)out;
    bf16 *QLb = (bf16*)(ob + S_QL), *QAb = (bf16*)(ob + S_QA), *CKVb = (bf16*)(ob + S_CKV), *KRb = (bf16*)(ob + S_KR), *cbk = (bf16*)(ob + S_CBK), *cbv = (bf16*)(ob + S_CBV);
    float* YF = out + O_Y; float* PARTb = (float*)(ws + W_PART); bf16* XH = (bf16*)(ws + W_XH); bf16* O1b = (bf16*)(ws + W_KV);
    cg::grid_group grid = cg::this_grid();
    const int lo = args.ph_lo, hi = args.ph_hi;
    volatile LAS unsigned* MISC = (volatile LAS unsigned*)(lds + 131072 + 320);
    if (tid < 32) MISC[tid] = 0u;
    __syncthreads();
    XcdBarrier xbar = xcd_barrier_post((unsigned*)(ws + 16384), MISC + 8);
    if (lo < 0) grid.sync();
#define IN(k) (lo <= (k) && (k) < hi)
#define SEAM(k) do { if (IN(k) && IN((k) + 1)) { for (int s_ = 0; s_ < PROBE_SYNC; ++s_) xcd_barrier(xbar); } } while (0)

    if (IN(0)) {
        LAS float* scr = (LAS float*)(lds + wave * 16384);
        constexpr int I0 = (DM / 64) * (IN_AB / 32), I1 = (768 / 64) * (768 / 32), I2 = (256 / 64) * (1024 / 32), I3 = (DM / 64) * (DM / 32), I4 = (DM / 64) * (IN_C / 32), I5 = I3,
                      I6 = (DM / 64) * (FF / 32), I7 = (FF / 64) * (DM / 32);
        constexpr int NIT = I0 + I1 + I2 + I3 + I4 + I5 + 2 * I6 + 2 * I7;
        for (int it = gw; it < NIT; it += NGW) { int r_ = it;
            if (r_ < I0) { transpose_item(w_in_ab, DM, IN_AB, Wt_inab, scr, r_, lane); continue; } r_ -= I0;
            if (r_ < I1) { transpose_item(w_uq, 768, 768, Wt_uq, scr, r_, lane, 0.10206207261596575f * LOG2E); continue; } r_ -= I1;
            if (r_ < I2) { transpose_item(w_ukv, 256, 1024, Wt_ukv, scr, r_, lane); continue; } r_ -= I2;
            if (r_ < I3) { transpose_item(w_out_ab, DM, DM, Wt_outab, scr, r_, lane); continue; } r_ -= I3;
            if (r_ < I4) { transpose_item(w_in_c, DM, IN_C, Wt_inc, scr, r_, lane, 0.125f * LOG2E, 1024); continue; } r_ -= I4;
            if (r_ < I5) { transpose_item(w_out_c, DM, DM, Wt_outc, scr, r_, lane); continue; } r_ -= I5;
            if (r_ < 2 * I6) { const int l = r_ / I6; transpose_item(w_up + (size_t)l * DM * FF, DM, FF, Wt_up + (size_t)l * DM * FF, scr, r_ % I6, lane); continue; } r_ -= 2 * I6;
            { const int l = r_ / I7; transpose_item(w_down + (size_t)l * DM * FF, FF, DM, Wt_down + (size_t)l * DM * FF, scr, r_ % I7, lane); }
        }
        for (size_t i = gt; i < (size_t)(IN_ABP - IN_AB) * DM / 8; i += gn) *(v4u*)(Wt_inab + (size_t)IN_AB * DM + i * 8) = (v4u){0u, 0u, 0u, 0u};
        cvt_rows(x_p, Xb, (size_t)MP * DM / 8, gt, gn);
        cvt_rows(x_s, Xb + (size_t)MP * DM, (size_t)MS * DM / 8, gt, gn);
        cvt_rows(c_ckv, CKVb + (size_t)M * 256, (size_t)DB * PAST * 256 / 8, gt, gn);
        cvt_rows(c_kr, KRb + (size_t)M * 32, (size_t)DB * PAST * 32 / 8, gt, gn);
        for (size_t i = gt; i < (size_t)SEQ * 16; i += gn) { const int pos = (int)(i >> 4), k = (int)(i & 15);
            const float inv = k == 0 ? 1.000000000e+00f : k == 1 ? 5.623413324e-01f : k == 2 ? 3.162277639e-01f : k == 3 ? 1.778279394e-01f : k == 4 ? 1.000000015e-01f : k == 5 ? 5.623413250e-02f : k == 6 ? 3.162277490e-02f : k == 7 ? 1.778279431e-02f :
                              k == 8 ? 9.999999776e-03f : k == 9 ? 5.623413250e-03f : k == 10 ? 3.162277630e-03f : k == 11 ? 1.778279431e-03f : k == 12 ? 1.000000047e-03f : k == 13 ? 5.623413017e-04f : k == 14 ? 3.162277571e-04f : 1.778279402e-04f;
            const float ang = (float)pos * inv; double tr = (double)ang * 0.15915494309189535; tr -= __builtin_floor(tr); const float fr = (float)tr;
            rope[i * 2] = __builtin_amdgcn_cosf(fr); rope[i * 2 + 1] = __builtin_amdgcn_sinf(fr); }
    }
    SEAM(0);
    if (IN(1)) { pg8::Gemm g{Xb, Wt_inab, M, IN_ABP, DM, DM}; pg8::StaticOrder S; S.init(M, IN_ABP, G, bx); pg8::EpiBf16<0> E{Hb, IN_ABP};
        pg8::gemm_phase<pg8::EpiBf16<0>, pg8::StaticOrder, true, true>(lds, g, S, E); }
    SEAM(1);
    if (IN(2)) {
#define P2_LOAD(S, m) \
        const bool ok##S = (m) < M; const int mm##S = ok##S ? (m) : 0; const bf16* hrow##S = Hb + (size_t)mm##S * IN_ABP; \
        const bool isp##S = mm##S < MP; const int ms##S = mm##S - MP; const int pos##S = isp##S ? (mm##S & (SEQ - 1)) : PAST + (ms##S & 63); \
        v2u vq##S[3]; _Pragma("unroll") for (int j = 0; j < 3; ++j) vq##S[j] = *(const v2u*)(hrow##S + lane * 4 + 256 * j); \
        const v2u vc##S = *(const v2u*)(hrow##S + 768 + lane * 4); \
        const unsigned short xr1##S = hrow##S[1024 + (lane & 15)], xr2##S = hrow##S[1040 + (lane & 15)]; \
        const float cs##S = rope[(size_t)pos##S * 32 + 2 * (lane & 15)], sn##S = rope[(size_t)pos##S * 32 + 2 * (lane & 15) + 1]; \
        float *dk##S = nullptr, *dv##S = nullptr; \
        if (isp##S) { const int t = mm##S & (SEQ - 1), b = mm##S >> 12; if (t >= SEQ - 512) { dk##S = out + O_BKP + ((size_t)b * 512 + t - (SEQ - 512)) * 512; dv##S = out + O_BVP + ((size_t)b * 512 + t - (SEQ - 512)) * 512; } } \
        else { const int b = ms##S >> 6, t = ms##S & 63; dk##S = out + O_BKS + ((size_t)b * 512 + 448 + t) * 512; dv##S = out + O_BVS + ((size_t)b * 512 + 448 + t) * 512; } \
        v4u kq##S = (v4u){0u, 0u, 0u, 0u}, vv##S = (v4u){0u, 0u, 0u, 0u}; if (dk##S) { kq##S = *(const v4u*)(hrow##S + 1568 + lane * 8); vv##S = *(const v4u*)(hrow##S + 2080 + lane * 8); }
#define P2_FIN(S) if (ok##S) { \
        { float f[12]; float ss = 0.f; \
            _Pragma("unroll") for (int j = 0; j < 3; ++j) { f[4 * j] = bflo(vq##S[j].x); f[4 * j + 1] = bfhi(vq##S[j].x); f[4 * j + 2] = bflo(vq##S[j].y); f[4 * j + 3] = bfhi(vq##S[j].y); } \
            _Pragma("unroll") for (int j = 0; j < 12; ++j) ss += f[j] * f[j]; \
            ss = wave_sum(ss); const float rs = rsqrtf(ss * (1.f / 768.f) + 1e-6f); \
            _Pragma("unroll") for (int j = 0; j < 3; ++j) { const f32x4 gv = *(const f32x4*)(g_q + lane * 4 + 256 * j); v2u o; o.x = pk2(f[4 * j] * rs * gv[0], f[4 * j + 1] * rs * gv[1]); o.y = pk2(f[4 * j + 2] * rs * gv[2], f[4 * j + 3] * rs * gv[3]); \
                *(v2u*)(QLb + (size_t)mm##S * 768 + lane * 4 + 256 * j) = o; } } \
        { const float a = bflo(vc##S.x), b = bfhi(vc##S.x), c = bflo(vc##S.y), d = bfhi(vc##S.y); \
            float ss = a * a + b * b + c * c + d * d; ss = wave_sum(ss); const float rs = rsqrtf(ss * (1.f / 256.f) + 1e-6f); \
            const f32x4 gv = *(const f32x4*)(g_kv + lane * 4); const f32x4 y = (f32x4){a * rs * gv[0], b * rs * gv[1], c * rs * gv[2], d * rs * gv[3]}; \
            float* dst = isp##S ? out + O_CKVP + (size_t)mm##S * 256 : out + O_CKVS + (size_t)ms##S * 256; *(f32x4*)(dst + lane * 4) = y; \
            v2u o; o.x = pk2(y[0], y[1]); o.y = pk2(y[2], y[3]); *(v2u*)(CKVb + (size_t)mm##S * 256 + lane * 4) = o; } \
        if (lane < 16) { const float x1 = bf1(xr1##S), x2 = bf1(xr2##S); \
            const float y1 = x1 * cs##S - x2 * sn##S, y2 = x2 * cs##S + x1 * sn##S; float* dst = isp##S ? out + O_KRP + (size_t)mm##S * 32 : out + O_KRS + (size_t)ms##S * 32; dst[lane] = y1; dst[lane + 16] = y2; \
            KRb[(size_t)mm##S * 32 + lane] = (bf16)f2bf(y1); KRb[(size_t)mm##S * 32 + 16 + lane] = (bf16)f2bf(y2); } \
        if (dk##S) { \
            *(f32x4*)(dk##S + lane * 8) = (f32x4){bflo(kq##S.x), bfhi(kq##S.x), bflo(kq##S.y), bfhi(kq##S.y)}; *(f32x4*)(dk##S + lane * 8 + 4) = (f32x4){bflo(kq##S.z), bfhi(kq##S.z), bflo(kq##S.w), bfhi(kq##S.w)}; \
            *(f32x4*)(dv##S + lane * 8) = (f32x4){bflo(vv##S.x), bfhi(vv##S.x), bflo(vv##S.y), bfhi(vv##S.y)}; *(f32x4*)(dv##S + lane * 8 + 4) = (f32x4){bflo(vv##S.z), bfhi(vv##S.z), bflo(vv##S.w), bfhi(vv##S.w)}; } }
        for (int m = gw; m < M; m += 4 * NGW) {
            P2_LOAD(A, m) P2_LOAD(B, m + NGW) P2_LOAD(C, m + 2 * NGW) P2_LOAD(D, m + 3 * NGW)
            P2_FIN(A) P2_FIN(B) P2_FIN(C) P2_FIN(D)
        }
#undef P2_LOAD
#undef P2_FIN
    }
    SEAM(2);
    if (IN(3)) {
        { pg8::Gemm g{QLb, Wt_uq, M, 768, 768, 768}; pg8::StaticOrder S; S.init(M, 768, G, bx); pg8::EpiBf16<0> E{QAb, 768};
          pg8::gemm_phase<pg8::EpiBf16<0>, pg8::StaticOrder, true, true>(lds, g, S, E); }
        { pg8::Gemm g{CKVb, Wt_ukv, MKV, 1024, 256, 256}; pg8::StaticOrder S; S.init(MKV, 1024, G, G - 1 - bx); pg8::EpiBf16<0> E{KVb, 1024};
          pg8::gemm_phase<pg8::EpiBf16<0>, pg8::StaticOrder, true, true>(lds, g, S, E); }
    }
    SEAM(3);
    for (int rep_ = 0; rep_ < PROBE_P4; ++rep_) if (IN(4)) {
        constexpr int NU = 2560;
        for (int rd = 0; rd * G < NU; ++rd) { const int i = rd * G + ((rd & 1) ? (G - 1 - bx) : bx); if (i >= NU) continue;
            att::AU U; U.kAf = nullptr; U.vAf = nullptr;
            if (i < 1024) { const int qb = 15 - (i >> 6), bh = i & 63, b = bh >> 3, h = bh & 7; const size_t r0 = (size_t)b * SEQ, rq = r0 + qb * 256;
                U.q = QAb + rq * 768 + h * 96; U.qp = 768; U.kA = KVb + r0 * 1024 + h * 128; U.vA = U.kA + 64; U.rA = KRb + r0 * 32; U.pA = 1024; U.kB = U.kA; U.vB = U.vA; U.rB = U.rA; U.pB = 1024;
                U.o = Ob + rq * 1024 + h * 64; U.op = 1024; U.ntA = 1 << 30; U.nrows = 256; U.qpos0 = qb * 256; U.h = h;
                att::attn_unit<0>(U, lds, rope, rel_bias); }
            else if (i < 2048) { const int j = i - 1024, qb = 15 - (j >> 6), bh = j & 63, b = bh >> 3, h = bh & 7; const size_t r0 = (size_t)b * SEQ, rq = r0 + qb * 256;
                U.q = Hb + rq * IN_ABP + 1056 + h * 64; U.qp = IN_ABP; U.kA = Hb + r0 * IN_ABP + 1568 + h * 64; U.vA = Hb + r0 * IN_ABP + 2080 + h * 64; U.rA = nullptr; U.pA = IN_ABP; U.kB = U.kA; U.vB = U.vA; U.rB = nullptr; U.pB = IN_ABP;
                U.o = Ob + rq * 1024 + 512 + h * 64; U.op = 1024; U.ntA = 1 << 30; U.nrows = 256; U.qpos0 = qb * 256; U.h = h;
                att::attn_unit<1>(U, lds, rope, rel_bias); }
            else if (i < 2304) { const int j = i - 2048, b = j >> 3, h = j & 7; const size_t rn = (size_t)MP + b * 64, rc = (size_t)M + (size_t)b * PAST;
                U.q = QAb + rn * 768 + h * 96; U.qp = 768; U.kA = KVb + rc * 1024 + h * 128; U.vA = U.kA + 64; U.rA = KRb + rc * 32; U.pA = 1024;
                U.kB = KVb + rn * 1024 + h * 128; U.vB = U.kB + 64; U.rB = KRb + rn * 32; U.pB = 1024;
                U.o = Ob + rn * 1024 + h * 64; U.op = 1024; U.ntA = 16; U.nrows = 64; U.qpos0 = PAST; U.h = h;
                att::attn_unit<0>(U, lds, rope, rel_bias); }
            else { const int j = i - 2304, b = j >> 3, h = j & 7; const size_t rn = (size_t)MP + b * 64;
                U.q = Hb + rn * IN_ABP + 1056 + h * 64; U.qp = IN_ABP; U.kA = nullptr; U.vA = nullptr; U.kAf = c_bk + (size_t)b * 512 * 512 + h * 64; U.vAf = c_bv + (size_t)b * 512 * 512 + h * 64; U.rA = nullptr; U.pA = 512;
                U.kB = Hb + rn * IN_ABP + 1568 + h * 64; U.vB = Hb + rn * IN_ABP + 2080 + h * 64; U.rB = nullptr; U.pB = IN_ABP;
                U.o = Ob + rn * 1024 + 512 + h * 64; U.op = 1024; U.ntA = 8; U.nrows = 64; U.qpos0 = 512; U.h = h;
                att::attn_unit<1>(U, lds, rope, rel_bias); }
        }
    }
    SEAM(4);
    if (IN(5)) { { pg8::Gemm g{Ob, Wt_outab, MP, DM, 1024, 1024}; pg8::StaticOrder S; S.init(MP, DM, G, bx); pg8::EpiResH<true> E{x_p, XH, DM, ALPHA};
          pg8::gemm_phase<pg8::EpiResH<true>, pg8::StaticOrder, true, true>(lds, g, S, E); }
        { pg8::Gemm g{Ob, Wt_outab, M, DM, 256, 1024}; pg8::SplitOrder S{MP / 256, DM / 256, 4, 256, 128, bx, G}; pg8::EpiPart E{PARTb, MP / 256, 256, MS, DM};
          pg8::gemm_phase<pg8::EpiPart, pg8::SplitOrder, true, true>(lds, g, S, E); } }
    SEAM(5);
#define LN_LOAD(v, m) do { if ((m) < MP) { _Pragma("unroll") for (int j = 0; j < 4; ++j) { const v2u q_ = *(const v2u*)(XH + (size_t)(m) * DM + lane * 4 + 256 * j); v[j] = (f32x4){bflo(q_.x), bfhi(q_.x), bflo(q_.y), bfhi(q_.y)}; } } \
        else if ((m) < M) { const size_t r_ = (size_t)((m) - MP); \
            if (RSF_) { _Pragma("unroll") for (int j = 0; j < 4; ++j) v[j] = *(const f32x4*)((RSF_) + r_ * DM + lane * 4 + 256 * j) * ALPHA; } \
            else { _Pragma("unroll") for (int j = 0; j < 4; ++j) { const v2u q_ = *(const v2u*)(Xb + (size_t)(m) * DM + lane * 4 + 256 * j); v[j] = (f32x4){bflo(q_.x), bfhi(q_.x), bflo(q_.y), bfhi(q_.y)} * ALPHA; } } \
            for (int ks = 0; ks < NSP_; ++ks) { const float* pp = PARTb + ((size_t)ks * MS + r_) * DM; _Pragma("unroll") for (int j = 0; j < 4; ++j) v[j] += *(const f32x4*)(pp + lane * 4 + 256 * j); } } \
        else { _Pragma("unroll") for (int j = 0; j < 4; ++j) v[j] = (f32x4){0.f, 0.f, 0.f, 0.f}; } } while (0)
#define LN_FINISH(v, m, gam, bet, FIN) do { float s = 0.f, s2 = 0.f; \
        _Pragma("unroll") for (int j = 0; j < 4; ++j) { s += (v[j][0] + v[j][1]) + (v[j][2] + v[j][3]); s2 += (v[j][0] * v[j][0] + v[j][1] * v[j][1]) + (v[j][2] * v[j][2] + v[j][3] * v[j][3]); } \
        const float mean = wave_sum(s) * (1.f / DM); const float var = fmaxf(wave_sum(s2) * (1.f / DM) - mean * mean, 0.f);     \
        _Pragma("unroll") for (int j = 0; j < 4; ++j) v[j] = v[j] - mean; \
        const float rstd = rsqrtf(var + 1e-5f); \
        if ((m) < M) { _Pragma("unroll") for (int j = 0; j < 4; ++j) { const f32x4 gv = *(const f32x4*)((gam) + lane * 4 + 256 * j), bv = *(const f32x4*)((bet) + lane * 4 + 256 * j); \
            const f32x4 y = v[j] * rstd * gv + bv; \
            if (FIN) *(f32x4*)(YF + (size_t)(m) * DM + lane * 4 + 256 * j) = y; \
            else { v2u o; o.x = pk2(y[0], y[1]); o.y = pk2(y[2], y[3]); *(v2u*)(Xb + (size_t)(m) * DM + lane * 4 + 256 * j) = o; } } } } while (0)
#define LN_PHASE(gam, bet, RSF, NS_, FIN) do { const float* RSF_ = (RSF); const int NSP_ = (NS_); \
        for (int m = gw; m < M; m += 4 * NGW) { const int mb = m + NGW, mc = m + 2 * NGW, md = m + 3 * NGW; f32x4 va[4], vb[4], vc[4], vd[4]; LN_LOAD(va, m); LN_LOAD(vb, mb); LN_LOAD(vc, mc); LN_LOAD(vd, md); \
            LN_FINISH(va, m, gam, bet, FIN); LN_FINISH(vb, mb, gam, bet, FIN); LN_FINISH(vc, mc, gam, bet, FIN); LN_FINISH(vd, md, gam, bet, FIN); } } while (0)
    if (IN(6)) LN_PHASE(ln_mix_g, ln_mix_b, x_s, 4, false);
    SEAM(6);
    if (IN(7)) { pg8::Gemm g{Xb, Wt_up, M, FF, DM, DM}; pg8::StaticOrder S; S.init(M, FF, G, bx); pg8::EpiBf16<2> E{Ub, FF};
        pg8::gemm_phase<pg8::EpiBf16<2>, pg8::StaticOrder, true, true>(lds, g, S, E); }
    SEAM(7);
    if (IN(8)) { { pg8::Gemm g{Ub, Wt_down, MP, DM, 4096, 4096}; pg8::StaticOrder S; S.init(MP, DM, G, bx); pg8::EpiResH<false> E{Xb, XH, DM, ALPHA};
          pg8::gemm_phase<pg8::EpiResH<false>, pg8::StaticOrder, true, true>(lds, g, S, E); }
        { pg8::Gemm g{Ub, Wt_down, M, DM, 512, 4096}; pg8::SplitOrder S{MP / 256, DM / 256, 8, 512, 256, bx, G}; pg8::EpiPart E{PARTb, MP / 256, 512, MS, DM};
          pg8::gemm_phase<pg8::EpiPart, pg8::SplitOrder, true, true>(lds, g, S, E); } }
    SEAM(8);
    if (IN(9)) { LN_PHASE(ln_ffn_g, ln_ffn_b, (const float*)nullptr, 8, false); }
    SEAM(9);
    if (IN(10)) { pg8::Gemm g{Xb, Wt_inc, M, IN_C, DM, DM}; pg8::StaticOrder S; S.init(M, IN_C, G, bx); typedef pg8::EpiQKV<O_SKP, O_SVP, O_SKS, O_SVS, MP, IN_C> EQ; EQ E{Hb, out};
        pg8::gemm_phase<EQ, pg8::StaticOrder, true, true>(lds, g, S, E);
        { const bool part = (G == 256); if (!part || bx >= 96) { const size_t gtx = part ? (size_t)(bx - 96) * 512 + tid : gt, gnx = part ? (size_t)160 * 512 : gn;
        for (size_t i = gtx; i < (size_t)DB * 448 * 128; i += gnx) { const size_t b = i / (448 * 128), rem = i % (448 * 128);
            *(f32x4*)(out + O_BKS + b * 512 * 512 + rem * 4) = *(const f32x4*)(c_bk + b * 512 * 512 + 64 * 512 + rem * 4);
            *(f32x4*)(out + O_BVS + b * 512 * 512 + rem * 4) = *(const f32x4*)(c_bv + b * 512 * 512 + 64 * 512 + rem * 4); }
        } } }
    SEAM(10);
    for (int rep_ = 0; rep_ < PROBE_P11; ++rep_) if (IN(11)) {
        constexpr int NU = 2048 + 128;
        for (int i = bx; i < NU; i += G) {
            if (i < 2048) sb_unit4<false>(Hb, c_sk, c_sv, O1b, i >> 8, (i >> 2) & 63, i & 3, lds);
            else { const int j = i - 2048; sb_unit4<true>(Hb, c_sk, c_sv, O1b, j >> 2, 0, j & 3, lds); }
        }
    }
    SEAM(11);
    if (IN(12)) { { pg8::Gemm g{O1b, Wt_outc, MP, DM, 1024, 1024}; pg8::StaticOrder S; S.init(MP, DM, G, bx); pg8::EpiResH<false> E{Xb, XH, DM, ALPHA};
          pg8::gemm_phase<pg8::EpiResH<false>, pg8::StaticOrder, true, true>(lds, g, S, E); }
        { pg8::Gemm g{O1b, Wt_outc, M, DM, 256, 1024}; pg8::SplitOrder S{MP / 256, DM / 256, 4, 256, 128, bx, G}; pg8::EpiPart E{PARTb, MP / 256, 256, MS, DM};
          pg8::gemm_phase<pg8::EpiPart, pg8::SplitOrder, true, true>(lds, g, S, E); } }
    SEAM(12);
    if (IN(13)) LN_PHASE(ln_mix_g + DM, ln_mix_b + DM, (const float*)nullptr, 4, false);
    SEAM(13);
    if (IN(14)) { pg8::Gemm g{Xb, Wt_up + (size_t)DM * FF, M, FF, DM, DM}; pg8::StaticOrder S; S.init(M, FF, G, bx); pg8::EpiBf16<2> E{Ub, FF};
        pg8::gemm_phase<pg8::EpiBf16<2>, pg8::StaticOrder, true, true>(lds, g, S, E); }
    SEAM(14);
    if (IN(15)) { { pg8::Gemm g{Ub, Wt_down + (size_t)DM * FF, MP, DM, 4096, 4096}; pg8::StaticOrder S; S.init(MP, DM, G, bx); pg8::EpiResH<false> E{Xb, XH, DM, ALPHA};
          pg8::gemm_phase<pg8::EpiResH<false>, pg8::StaticOrder, true, true>(lds, g, S, E); }
        { pg8::Gemm g{Ub, Wt_down + (size_t)DM * FF, M, DM, 512, 4096}; pg8::SplitOrder S{MP / 256, DM / 256, 8, 512, 256, bx, G}; pg8::EpiPart E{PARTb, MP / 256, 512, MS, DM};
          pg8::gemm_phase<pg8::EpiPart, pg8::SplitOrder, true, true>(lds, g, S, E); } }
    SEAM(15);
    if (IN(16)) LN_PHASE(ln_ffn_g + DM, ln_ffn_b + DM, (const float*)nullptr, 8, true);
#undef IN
#undef SEAM
}

#ifndef MK_MULTI
#define MK_MULTI 0
#endif
extern "C" void kernel_launch(void* const* d_in, const int* in_sizes, int n_in, void* d_out, int out_size, void* d_ws, size_t ws_size, hipStream_t stream) {
    static int grid = 0;
    if (grid == 0) {
        if (n_in != 23 || (size_t)out_size != O_END || ws_size < W_END2) { fprintf(stderr, "kernel_launch: unexpected shapes: n_in %d out %d ws %zu (need %zu)\n", n_in, out_size, ws_size, (size_t)W_END); grid = -1; return; }
        int dev = 0, cus = 0, per_cu = 0;
        hipGetDevice(&dev); hipDeviceGetAttribute(&cus, hipDeviceAttributeMultiprocessorCount, dev);
        if (hipFuncSetAttribute((const void*)fwd, hipFuncAttributeMaxDynamicSharedMemorySize, LDS_BYTES) != hipSuccess) { fprintf(stderr, "kernel_launch: hipFuncSetAttribute failed\n"); grid = -1; return; }
        if (hipOccupancyMaxActiveBlocksPerMultiprocessor(&per_cu, (const void*)fwd, 512, LDS_BYTES) != hipSuccess || per_cu < 1) { fprintf(stderr, "kernel_launch: occupancy query says %d\n", per_cu); per_cu = 1; }
        (void)hipGetLastError();
        grid = cus;
    }
    if (grid < 0) return;
    if (hipMemsetAsync(d_ws, 0, 65536, stream) != hipSuccess) { fprintf(stderr, "kernel_launch: memset failed\n"); return; }
    Args a{};
    for (int i = 0; i < 23; ++i) a.in[i] = (const float*)d_in[i];
    a.out = (float*)d_out; a.ws = (unsigned char*)d_ws;
#if MK_MULTI
    for (int p = 0; p < NPH; ++p) { a.ph_lo = p; a.ph_hi = p + 1; hipLaunchKernelGGL(fwd, dim3(grid), dim3(512), LDS_BYTES, stream, a); }
#else
    a.ph_lo = 0; a.ph_hi = NPH;
    void* kargs[] = {&a};
    hipError_t e = hipLaunchCooperativeKernel((const void*)fwd, dim3(grid), dim3(512), kargs, LDS_BYTES, stream);
    if (e != hipSuccess) fprintf(stderr, "cooperative launch failed: %s (grid %d)\n", hipGetErrorString(e), grid);
#endif
}
```

```cpp
#include <hip/hip_runtime.h>
#include <hip/hip_bf16.h>
namespace pg8 {
#define PG8_LAS __attribute__((address_space(3)))
typedef unsigned short bf16_t;
typedef short bf16x8 __attribute__((ext_vector_type(8)));
typedef float f32x4 __attribute__((ext_vector_type(4)));
typedef unsigned u32x4 __attribute__((ext_vector_type(4)));
constexpr int BM = 256, BK = 64, HALF = 128, HTB = HALF * BK * 2  , STAGE_BYTES = 8 * HTB, NXCD = 8, WGM = 8;

__host__ __device__ __forceinline__ int lds_byte(int r, int c) { const int st = (r >> 4) * 2 + (c >> 5), rr = r & 15, cc = c & 31, ob = rr * 64 + cc * 2; return st * 1024 + (ob ^ (((ob >> 9) & 1) << 5)); }
__host__ __device__ __forceinline__ void stage_rc(int b, int& R, int& C) { const int st = b / 1024, sb = b % 1024, swz = sb ^ (((sb >> 9) & 1) << 5); R = (st >> 1) * 16 + swz / 64; C = (st & 1) * 32 + (swz % 64) / 2; }
__host__ __device__ __forceinline__ int perm32(int rho) { const int n = rho >> 4, i = rho & 15; return 8 * (i >> 2) + 4 * n + (i & 3); }

struct Unit { int pm, pn, ko; };
struct Gemm { const bf16_t* A; const bf16_t* Bt; int M, N, K, ld; };

struct StaticOrder {
    int nM, nN, nwg, G, c;
    __host__ __device__ void init(int M, int N, int G_, int c_) { nM = M / BM; nN = N / BM; nwg = nM * nN; G = G_; c = c_; }
    __host__ __device__ bool next(int i, Unit& u) const {
        const long L = (long)i * G + c; if (L >= nwg) return false;
        int wgid = (int)L; { const int q = nwg / NXCD, r = nwg % NXCD, xcd = wgid % NXCD, off = wgid / NXCD; wgid = (xcd < r ? xcd * (q + 1) : r * (q + 1) + (xcd - r) * q) + off; }
        const int nig = WGM * nN, gid = wgid / nig, fm = gid * WGM, gsz = (nM - fm) < WGM ? (nM - fm) : WGM;
        u.pm = fm + ((wgid % nig) % gsz); u.pn = (wgid % nig) / gsz; u.ko = 0; return true;
    }
    __device__ __forceinline__ void a_ready(const Unit&) const {}
    __device__ __forceinline__ void done(const Unit&) const {}
};
typedef float f32x2 __attribute__((ext_vector_type(2))); typedef __bf16 bf16x2v __attribute__((ext_vector_type(2)));
__device__ __forceinline__ unsigned cvt_pk_bf16(float lo, float hi) { f32x2 v = {lo, hi}; bf16x2v b = __builtin_convertvector(v, bf16x2v); return __builtin_bit_cast(unsigned, b); }
template <int ACT  > struct EpiBf16 {
    static constexpr bool PERM = true, AFTER_DRAIN = false;
    bf16_t* O; int ldc;
    __device__ __forceinline__ void operator()(const f32x4 (&acc)[2][2][4][2], const Unit& u, int wr, int wc, int fr, int fq) const {
        const int row0 = u.pm * BM + wr * 64 + fr; const int col0 = u.pn * BM + wc * 32 + 8 * fq;
#pragma unroll
        for (int ai = 0; ai < 2; ++ai)
#pragma unroll
            for (int m = 0; m < 4; ++m) { bf16_t* rowp = O + (size_t)(row0 + ai * HALF + m * 16) * ldc + col0;
#pragma unroll
                for (int bj = 0; bj < 2; ++bj) { f32x4 v0 = acc[ai][bj][m][0], v1 = acc[ai][bj][m][1];
                    if (ACT == 2) {
#pragma unroll
                        for (int e = 0; e < 4; ++e) { float a = fmaxf(v0[e], 0.f), b = fmaxf(v1[e], 0.f); v0[e] = a * a; v1[e] = b * b; } }
                    u32x4 w; w.x = cvt_pk_bf16(v0[0], v0[1]); w.y = cvt_pk_bf16(v0[2], v0[3]); w.z = cvt_pk_bf16(v1[0], v1[1]); w.w = cvt_pk_bf16(v1[2], v1[3]);
                    *(u32x4*)(rowp + bj * HALF) = w; } }
    }
};
struct EpiResF32 {
    static constexpr bool PERM = false, AFTER_DRAIN = false;
    const float* r0; const float* r1; int split; float* out; int ldc; float alpha;
    __device__ __forceinline__ void operator()(const f32x4 (&acc)[2][2][4][2], const Unit& u, int wr, int wc, int fr, int fq) const {
        const int col0 = u.pn * BM + wc * 32 + 4 * fq;
#pragma unroll
        for (int ai = 0; ai < 2; ++ai)
#pragma unroll
            for (int m = 0; m < 4; ++m) { const int row = u.pm * BM + ai * HALF + wr * 64 + m * 16 + fr;
                const float* rp = (row < split) ? r0 + (size_t)row * ldc : r1 + (size_t)(row - split) * ldc;
                float* op = out + (size_t)row * ldc;
#pragma unroll
                for (int bj = 0; bj < 2; ++bj)
#pragma unroll
                    for (int n = 0; n < 2; ++n) { const int c = col0 + bj * HALF + n * 16; const f32x4 rv = *(const f32x4*)(rp + c);
                        *(f32x4*)(op + c) = rv * alpha + acc[ai][bj][m][n]; } }
    }
};
template <size_t KP, size_t VP, size_t KS, size_t VS, int split, int ldc> struct EpiQKV {
    static constexpr bool PERM = true, AFTER_DRAIN = false;
    bf16_t* O; float* outp;
    __device__ __forceinline__ void operator()(const f32x4 (&acc)[2][2][4][2], const Unit& u, int wr, int wc, int fr, int fq) const {
        const int row0 = u.pm * BM + wr * 64 + fr; const int col0 = u.pn * BM + wc * 32 + 8 * fq;
        const int sel = u.pn >> 2;
        if (sel) {
            float* fbase = outp + (sel == 1 ? (u.pm * BM < split ? KP : KS) : (u.pm * BM < split ? VP : VS));
            fbase += (size_t)(row0 - (u.pm * BM < split ? 0 : split)) * 1024 + (col0 - sel * 1024);
#pragma unroll
            for (int ai = 0; ai < 2; ++ai)
#pragma unroll
                for (int m = 0; m < 4; ++m) { float* frow = fbase + (ai * HALF + m * 16) * 1024;
#pragma unroll
                    for (int bj = 0; bj < 2; ++bj) { __builtin_nontemporal_store(acc[ai][bj][m][0], (f32x4*)(frow + bj * HALF)); __builtin_nontemporal_store(acc[ai][bj][m][1], (f32x4*)(frow + bj * HALF + 4)); }
                    asm volatile("" ::: "memory"); }
        }
        bf16_t* obase = O + (size_t)row0 * ldc + col0;
#pragma unroll
        for (int ai = 0; ai < 2; ++ai)
#pragma unroll
            for (int m = 0; m < 4; ++m) { bf16_t* rowp = obase + (size_t)(ai * HALF + m * 16) * ldc;
#pragma unroll
                for (int bj = 0; bj < 2; ++bj) { const f32x4 v0 = acc[ai][bj][m][0], v1 = acc[ai][bj][m][1];
                    u32x4 w; w.x = cvt_pk_bf16(v0[0], v0[1]); w.y = cvt_pk_bf16(v0[2], v0[3]); w.z = cvt_pk_bf16(v1[0], v1[1]); w.w = cvt_pk_bf16(v1[2], v1[3]);
                    *(u32x4*)(rowp + bj * HALF) = w; }
                asm volatile("" ::: "memory"); }
    }
};
struct SplitOrder {
    int pm0, nN, S, Ksub, nunits, c, G;
    __device__ __forceinline__ bool next(int i, Unit& u) const { const int L = i * G + c; if (L >= nunits) return false; const int t = L / S, ks = L % S; u.pm = pm0 + t / nN; u.pn = t % nN; u.ko = ks * Ksub; return true; }
    __device__ __forceinline__ void a_ready(const Unit&) const {}
    __device__ __forceinline__ void done(const Unit&) const {}
};
struct EpiPart {
    static constexpr bool PERM = false, AFTER_DRAIN = false;
    float* part; int pm0, Ksub, rows, ldc;
    __device__ __forceinline__ void operator()(const f32x4 (&acc)[2][2][4][2], const Unit& u, int wr, int wc, int fr, int fq) const {
        const int col0 = u.pn * BM + wc * 32 + 4 * fq; float* base = part + ((size_t)(u.ko / Ksub) * rows + (size_t)(u.pm - pm0) * BM) * ldc;
#pragma unroll
        for (int ai = 0; ai < 2; ++ai)
#pragma unroll
            for (int m = 0; m < 4; ++m) { float* op = base + (size_t)(ai * HALF + wr * 64 + m * 16 + fr) * ldc;
#pragma unroll
                for (int bj = 0; bj < 2; ++bj)
#pragma unroll
                    for (int n = 0; n < 2; ++n) *(f32x4*)(op + col0 + bj * HALF + n * 16) = acc[ai][bj][m][n]; }
    }
};
template <bool RF32> struct EpiResH {
    static constexpr bool PERM = true, AFTER_DRAIN = false;
    const void* res; bf16_t* out; int ldc; float alpha;
    __device__ __forceinline__ void operator()(const f32x4 (&acc)[2][2][4][2], const Unit& u, int wr, int wc, int fr, int fq) const {
        const int row0 = u.pm * BM + wr * 64 + fr; const int col0 = u.pn * BM + wc * 32 + 8 * fq;
#pragma unroll
        for (int ai = 0; ai < 2; ++ai)
#pragma unroll
            for (int m = 0; m < 4; ++m) { const size_t off = (size_t)(row0 + ai * HALF + m * 16) * ldc + col0;
#pragma unroll
                for (int bj = 0; bj < 2; ++bj) { f32x4 r0, r1;
                    if (RF32) { r0 = *(const f32x4*)((const float*)res + off + bj * HALF); r1 = *(const f32x4*)((const float*)res + off + bj * HALF + 4); }
                    else { const u32x4 q = *(const u32x4*)((const bf16_t*)res + off + bj * HALF);
                        r0 = (f32x4){__builtin_bit_cast(float, q.x << 16), __builtin_bit_cast(float, q.x & 0xffff0000u), __builtin_bit_cast(float, q.y << 16), __builtin_bit_cast(float, q.y & 0xffff0000u)};
                        r1 = (f32x4){__builtin_bit_cast(float, q.z << 16), __builtin_bit_cast(float, q.z & 0xffff0000u), __builtin_bit_cast(float, q.w << 16), __builtin_bit_cast(float, q.w & 0xffff0000u)}; }
                    const f32x4 v0 = r0 * alpha + acc[ai][bj][m][0], v1 = r1 * alpha + acc[ai][bj][m][1];
                    u32x4 w; w.x = cvt_pk_bf16(v0[0], v0[1]); w.y = cvt_pk_bf16(v0[2], v0[3]); w.z = cvt_pk_bf16(v1[0], v1[1]); w.w = cvt_pk_bf16(v1[2], v1[3]);
                    *(u32x4*)(out + off + bj * HALF) = w; }
                if (m & 1) asm volatile("" ::: "memory"); }
    }
};
template <class Epi, class Sched, bool ALIGN_EPI = false, bool SP2 = false>
__device__ __forceinline__ void gemm_phase(PG8_LAS unsigned char* lds, const Gemm g, const Sched& S, const Epi& E) {
    const int tid = threadIdx.x, wid = __builtin_amdgcn_readfirstlane(tid >> 6), lane = tid & 63, wr = wid >> 2, wc = wid & 3, fr = lane & 15, fq = lane >> 4;
    const int K = g.K, LD = g.ld, nt = K / BK;
    unsigned voffA[2], voffB[2];
#pragma unroll
    for (int i = 0; i < 2; ++i) { int R, C; stage_rc(tid * 16 + i * 8192, R, C); const int Rb = Epi::PERM ? ((R & ~31) + perm32(R & 31)) : R;
        voffA[i] = (unsigned)(R * LD + C) * 2u; voffB[i] = (unsigned)(Rb * LD + C) * 2u; }
    const size_t kstep = (size_t)(BK * 2);
    const size_t hstep = (size_t)HALF * LD * 2;
    const size_t tstep = 2 * hstep;
    const unsigned ldsw = (unsigned)wid * 1024u;
    const int aoff = lds_byte(wr * 64 + fr, fq * 8), boff = lds_byte(wc * 32 + fr, fq * 8);
#define PG8_SA(b, h) (((b) * 2 + (h)) * HTB)
#define PG8_SB(b, h) ((4 + (b) * 2 + (h)) * HTB)
#define PG8_STAGE(bufoff, gbase, voff) do { _Pragma("unroll") for (int _i = 0; _i < 2; ++_i) \
        __builtin_amdgcn_global_load_lds((const unsigned*)((const char*)(gbase) + (voff)[_i]), (PG8_LAS unsigned*)(lds + (bufoff) + ldsw + _i * 8192), 16, 0, 0); } while (0)
#define PG8_LDA(dst, b, h) do { _Pragma("unroll") for (int m = 0; m < 4; ++m) _Pragma("unroll") for (int k = 0; k < 2; ++k) dst[m][k] = *(const PG8_LAS bf16x8*)(lds + PG8_SA(b, h) + aoff + m * 2048 + k * 1024); } while (0)
#define PG8_LDB(dst, b, h) do { _Pragma("unroll") for (int n = 0; n < 2; ++n) _Pragma("unroll") for (int k = 0; k < 2; ++k) dst[n][k] = *(const PG8_LAS bf16x8*)(lds + PG8_SB(b, h) + boff + n * 2048 + k * 1024); } while (0)
#define PG8_MMA(ai, bj, At, Bt) do { __builtin_amdgcn_s_setprio(1); _Pragma("unroll") for (int m = 0; m < 4; ++m) _Pragma("unroll") for (int n = 0; n < 2; ++n) _Pragma("unroll") for (int k = 0; k < 2; ++k) \
        acc[ai][bj][m][n] = __builtin_amdgcn_mfma_f32_16x16x32_bf16(Bt[n][k], At[m][k], acc[ai][bj][m][n], 0, 0, 0); __builtin_amdgcn_s_setprio(0); } while (0)
#define PG8_WAIT_V(n) asm volatile("s_waitcnt vmcnt(" #n ")" ::: "memory")
#define PG8_WAIT_L(n) asm volatile("s_waitcnt lgkmcnt(" #n ")" ::: "memory")
#define PG8_BAR __builtin_amdgcn_s_barrier()
#define PG8_SCHED __builtin_amdgcn_sched_barrier(0)
    Unit cur, nxt; int ui = 0;
    if (!S.next(0, cur)) return;
    f32x4 acc[2][2][4][2];
#pragma unroll
    for (int a = 0; a < 2; ++a)
#pragma unroll
        for (int b = 0; b < 2; ++b)
#pragma unroll
            for (int m = 0; m < 4; ++m)
#pragma unroll
                for (int n = 0; n < 2; ++n) acc[a][b][m][n] = (f32x4){0.f, 0.f, 0.f, 0.f};
    bf16x8 At[4][2], B0[2][2], B1[2][2];
    const char* cA = (const char*)g.A + (size_t)cur.pm * tstep + (size_t)cur.ko * 2; const char* cB = (const char*)g.Bt + (size_t)cur.pn * tstep + (size_t)cur.ko * 2;
    S.a_ready(cur);
    if constexpr (SP2) {
        PG8_STAGE(PG8_SB(0, 0), cB, voffB); PG8_STAGE(PG8_SB(0, 1), cB + hstep, voffB); PG8_STAGE(PG8_SA(0, 0), cA, voffA); PG8_STAGE(PG8_SA(0, 1), cA + hstep, voffA);
        if (wr == 1) PG8_BAR;
        PG8_WAIT_V(2); PG8_BAR;
        PG8_STAGE(PG8_SB(1, 0), cB + kstep, voffB); PG8_STAGE(PG8_SA(1, 0), cA + kstep, voffA); PG8_STAGE(PG8_SB(1, 1), cB + hstep + kstep, voffB);
        PG8_WAIT_V(6); PG8_BAR;
    } else {
        PG8_STAGE(PG8_SB(0, 0), cB, voffB); PG8_STAGE(PG8_SA(0, 0), cA, voffA); PG8_STAGE(PG8_SB(0, 1), cB + hstep, voffB); PG8_STAGE(PG8_SA(0, 1), cA + hstep, voffA);
        if (wr == 1) PG8_BAR;
        PG8_WAIT_V(4); PG8_BAR;
        PG8_STAGE(PG8_SB(1, 0), cB + kstep, voffB); PG8_STAGE(PG8_SA(1, 0), cA + kstep, voffA); PG8_STAGE(PG8_SB(1, 1), cB + hstep + kstep, voffB);
        PG8_WAIT_V(6); PG8_BAR;
    }
    for (;;) {
        const bool has_next = S.next(ui + 1, nxt);
        const char* nA = has_next ? (const char*)g.A + (size_t)nxt.pm * tstep + (size_t)nxt.ko * 2 : cA; const char* nB = has_next ? (const char*)g.Bt + (size_t)nxt.pn * tstep + (size_t)nxt.ko * 2 : cB;
        for (int t = 0; t < nt; t += 2) {
            const bool last = (t == nt - 2);
            const char* a1 = cA + (size_t)(t + 1) * kstep;
            const char* a2 = last ? nA : cA + (size_t)(t + 2) * kstep; const char* b2 = last ? nB : cB + (size_t)(t + 2) * kstep;
            const char* a3 = a2 + kstep; const char* b3 = b2 + kstep;
            if (last && has_next) S.a_ready(nxt);
            if constexpr (SP2) {
            PG8_LDB(B0, 0, 0); PG8_LDB(B1, 0, 1); PG8_SCHED; PG8_LDA(At, 0, 0); PG8_STAGE(PG8_SA(1, 1), a1 + hstep, voffA);
            PG8_WAIT_V(8); PG8_WAIT_L(0); PG8_BAR; PG8_MMA(0, 0, At, B0); PG8_MMA(0, 1, At, B1); PG8_BAR; PG8_SCHED;
            PG8_LDA(At, 0, 1); PG8_STAGE(PG8_SB(0, 0), b2, voffB); PG8_STAGE(PG8_SB(0, 1), b2 + hstep, voffB); PG8_STAGE(PG8_SA(0, 0), a2, voffA);
            PG8_WAIT_V(8); PG8_WAIT_L(0); PG8_BAR; PG8_MMA(1, 0, At, B0); PG8_MMA(1, 1, At, B1); PG8_BAR; PG8_SCHED;
            PG8_LDB(B0, 1, 0); PG8_LDB(B1, 1, 1); PG8_SCHED; PG8_LDA(At, 1, 0); PG8_STAGE(PG8_SA(0, 1), a2 + hstep, voffA);
            PG8_WAIT_V(8); PG8_WAIT_L(0); PG8_BAR; PG8_MMA(0, 0, At, B0); PG8_MMA(0, 1, At, B1); PG8_BAR; PG8_SCHED;
            PG8_LDA(At, 1, 1); PG8_STAGE(PG8_SB(1, 0), b3, voffB); PG8_STAGE(PG8_SB(1, 1), b3 + hstep, voffB); PG8_STAGE(PG8_SA(1, 0), a3, voffA);
            PG8_WAIT_V(8); PG8_WAIT_L(0); PG8_BAR; PG8_MMA(1, 0, At, B0); PG8_MMA(1, 1, At, B1); PG8_BAR; PG8_SCHED;
            } else {
            PG8_LDB(B0, 0, 0); PG8_SCHED; PG8_LDA(At, 0, 0); PG8_STAGE(PG8_SA(1, 1), a1 + hstep, voffA);
            PG8_WAIT_L(8); PG8_BAR; PG8_WAIT_L(0); PG8_MMA(0, 0, At, B0); PG8_BAR; PG8_SCHED;
            PG8_LDB(B1, 0, 1); PG8_STAGE(PG8_SB(0, 0), b2, voffB);
            PG8_BAR; PG8_WAIT_L(0); PG8_MMA(0, 1, At, B1); PG8_BAR;
            PG8_LDA(At, 0, 1); PG8_STAGE(PG8_SA(0, 0), a2, voffA);
            PG8_BAR; PG8_WAIT_L(0); PG8_MMA(1, 0, At, B0); PG8_BAR; PG8_SCHED;
            PG8_STAGE(PG8_SB(0, 1), b2 + hstep, voffB);
            PG8_WAIT_V(6); PG8_BAR; PG8_MMA(1, 1, At, B1); PG8_BAR;
            PG8_LDB(B0, 1, 0); PG8_SCHED; PG8_LDA(At, 1, 0); PG8_STAGE(PG8_SA(0, 1), a2 + hstep, voffA);
            PG8_WAIT_L(8); PG8_BAR; PG8_WAIT_L(0); PG8_MMA(0, 0, At, B0); PG8_BAR; PG8_SCHED;
            PG8_LDB(B1, 1, 1); PG8_STAGE(PG8_SB(1, 0), b3, voffB);
            PG8_BAR; PG8_WAIT_L(0); PG8_MMA(0, 1, At, B1); PG8_BAR;
            PG8_LDA(At, 1, 1); PG8_STAGE(PG8_SA(1, 0), a3, voffA);
            PG8_BAR; PG8_WAIT_L(0); PG8_MMA(1, 0, At, B0); PG8_BAR; PG8_SCHED;
            PG8_STAGE(PG8_SB(1, 1), b3 + hstep, voffB);
            PG8_WAIT_V(6); PG8_BAR; PG8_MMA(1, 1, At, B1); PG8_BAR;
            }
        }
        if constexpr (ALIGN_EPI) { if (wr == 0) PG8_BAR; }
        if constexpr (!Epi::AFTER_DRAIN) { E(acc, cur, wr, wc, fr, fq); S.done(cur); }
        if (!has_next) break;
#pragma unroll
        for (int a = 0; a < 2; ++a)
#pragma unroll
            for (int b = 0; b < 2; ++b)
#pragma unroll
                for (int m = 0; m < 4; ++m)
#pragma unroll
                    for (int n = 0; n < 2; ++n) acc[a][b][m][n] = (f32x4){0.f, 0.f, 0.f, 0.f};
        cur = nxt; cA = nA; cB = nB; ++ui;
        if constexpr (ALIGN_EPI) { if (wr == 1) PG8_BAR; }
    }
    PG8_WAIT_V(0);
    if constexpr (!ALIGN_EPI) { if (wr == 0) PG8_BAR; }
    PG8_BAR;
    if constexpr (Epi::AFTER_DRAIN) { E.fused(acc, cur, wr, wc, fr, fq, lds, wid, lane); S.done(cur); }
#undef PG8_SA
#undef PG8_SB
#undef PG8_STAGE
#undef PG8_LDA
#undef PG8_LDB
#undef PG8_MMA
#undef PG8_WAIT_V
#undef PG8_WAIT_L
#undef PG8_BAR
#undef PG8_SCHED
}
}

#include <hip/hip_cooperative_groups.h>
#include <cstdio>
#include <cstdint>
namespace cg = cooperative_groups;
#define GAS __attribute__((address_space(1)))
#define LAS __attribute__((address_space(3)))
typedef unsigned short bf16;
typedef unsigned v4u __attribute__((ext_vector_type(4)));
typedef unsigned v2u __attribute__((ext_vector_type(2)));
typedef float f32x4 __attribute__((ext_vector_type(4)));
typedef float f32x16 __attribute__((ext_vector_type(16)));
typedef short bf16x8 __attribute__((ext_vector_type(8)));
typedef short v4i16_t __attribute__((ext_vector_type(4)));
#define LDS_WAIT() asm volatile("s_waitcnt lgkmcnt(0)" ::: "memory")
__device__ __forceinline__ unsigned f2bf(float f) { unsigned u = __builtin_bit_cast(unsigned, f); return (u + 0x7fffu + ((u >> 16) & 1u)) >> 16; }
typedef float f32x2_t __attribute__((ext_vector_type(2))); typedef __bf16 bf16x2_t __attribute__((ext_vector_type(2)));
__device__ __forceinline__ unsigned pk2(float lo, float hi) { f32x2_t v = {lo, hi}; bf16x2_t b = __builtin_convertvector(v, bf16x2_t); return __builtin_bit_cast(unsigned, b); }
__device__ __forceinline__ float bflo(unsigned w) { return __builtin_bit_cast(float, w << 16); }
__device__ __forceinline__ float bfhi(unsigned w) { return __builtin_bit_cast(float, w & 0xffff0000u); }
__device__ __forceinline__ float bf1(unsigned short s) { return __builtin_bit_cast(float, (unsigned)s << 16); }

constexpr int DM = 1024, SEQ = 4096, NB = 8, DB = 32, DS = 64, PAST = 1024;
constexpr int MP = NB * SEQ, MS = DB * DS, M = MP + MS;
constexpr int IN_AB = 2592, IN_ABP = 2816, IN_C = 3072, FF = 4096, QL = 768, KVL = 256;
constexpr int MKV = M + DB * PAST;
constexpr float ALPHA = 1.4142135623730951f;
constexpr float LOG2E = 1.4426950408889634f;

constexpr size_t O_Y = 0, O_CKVP = 35651584, O_KRP = 44040192, O_BKP = 45088768, O_BVP = 47185920, O_SKP = 49283072, O_SVP = 82837504,
                 O_CKVS = 116391936, O_KRS = 116916224, O_BKS = 116981760, O_BVS = 125370368, O_SKS = 133758976, O_SVS = 135856128, O_END = 137953280;
constexpr size_t W_INAB = 1u << 20, W_UQ = W_INAB + (size_t)IN_ABP * DM * 2, W_UKV = W_UQ + (size_t)768 * 768 * 2, W_OUTAB = W_UKV + (size_t)1024 * 256 * 2,
                 W_INC = W_OUTAB + (size_t)DM * DM * 2, W_OUTC = W_INC + (size_t)IN_C * DM * 2, W_UP = W_OUTC + (size_t)DM * DM * 2, W_DOWN = W_UP + (size_t)2 * FF * DM * 2,
                 W_ROPE = W_DOWN + (size_t)2 * FF * DM * 2, W_XB = W_ROPE + (size_t)SEQ * 32 * 4, W_H = W_XB + (size_t)M * DM * 2, W_KV = W_H + (size_t)M * IN_C * 2,
                 W_END = W_KV + (size_t)MKV * 1024 * 2;
constexpr size_t W_PART = W_END, W_XH = W_PART + (size_t)8 * MS * DM * 4, W_END2 = W_XH + (size_t)M * DM * 2;
static_assert((size_t)M * FF * 2 <= W_END - W_H, "U overlay");
static_assert((size_t)2 * DB * PAST * 1024 * 2 <= W_END - W_KV, "csb overlay");
constexpr size_t S_QL = O_SKP * 4, S_QA = S_QL + (size_t)M * 768 * 2;
constexpr size_t S_CKV = O_SVP * 4, S_KR = S_CKV + (size_t)MKV * 256 * 2, S_CBK = S_KR + (size_t)MKV * 32 * 2, S_CBV = S_CBK + (size_t)DB * 512 * 512 * 2, S_END2 = S_CBV + (size_t)DB * 512 * 512 * 2;
static_assert(S_QA + (size_t)M * 768 * 2 <= O_SVP * 4 && S_END2 <= O_CKVS * 4, "d_out scratch");

constexpr int LDS_BYTES = 147456;

struct Args {
    const float* in[23]; float* out; unsigned char* ws; int ph_lo, ph_hi;
};

#define dpp_add(v, old, ctrl, rmask) __builtin_bit_cast(float, __builtin_amdgcn_update_dpp(__builtin_bit_cast(int, (float)(old)), __builtin_bit_cast(int, (float)(v)), (ctrl), (rmask), 0xF, false))
__device__ __forceinline__ float wave_sum(float v) {
    v += dpp_add(v, 0.f, 0xB1, 0xF);
    v += dpp_add(v, 0.f, 0x4E, 0xF);
    v += dpp_add(v, 0.f, 0x141, 0xF);
    v += dpp_add(v, 0.f, 0x140, 0xF);
    v += dpp_add(v, 0.f, 0x142, 0xA);
    v += dpp_add(v, 0.f, 0x143, 0xC);
    return __builtin_bit_cast(float, __builtin_amdgcn_readlane(__builtin_bit_cast(int, v), 63));
}
__device__ __forceinline__ void transpose_item(const float* W, int K, int N, bf16* WT, LAS float* scr, int item, int lane, float sc0 = 1.f, int nlim = 1 << 30) {
    const int nblk = N / 32, kb = item / nblk, nb = item % nblk, k0 = 64 * kb, n0 = 32 * nb; const float sc = n0 < nlim ? sc0 : 1.f;
#pragma unroll 8
    for (int i = 0; i < 32; ++i) { const int kk = 2 * i + (lane >> 5); scr[kk * 33 + (lane & 31)] = W[(size_t)(k0 + kk) * N + n0 + (lane & 31)] * sc; }
    LDS_WAIT(); asm volatile("" ::: "memory");
    const int c = lane & 7;
#pragma unroll
    for (int j = 0; j < 4; ++j) { const int n = (lane >> 3) + 8 * j; const LAS float* s = scr + (8 * c) * 33 + n;
        v4u o; o.x = pk2(s[0 * 33], s[1 * 33]); o.y = pk2(s[2 * 33], s[3 * 33]); o.z = pk2(s[4 * 33], s[5 * 33]); o.w = pk2(s[6 * 33], s[7 * 33]);
        *(v4u*)(WT + (size_t)(n0 + n) * K + k0 + 8 * c) = o; }
    LDS_WAIT(); asm volatile("" ::: "memory");
}
__device__ __forceinline__ void cvt_rows(const float* src, bf16* dst, size_t n8, size_t gt, size_t gn) {
    for (size_t i = gt; i < n8; i += gn) { const f32x4 a = __builtin_nontemporal_load((const f32x4*)(src + i * 8)), b = __builtin_nontemporal_load((const f32x4*)(src + i * 8 + 4));
        v4u o; o.x = pk2(a[0], a[1]); o.y = pk2(a[2], a[3]); o.z = pk2(b[0], b[1]); o.w = pk2(b[2], b[3]); *(v4u*)(dst + i * 8) = o; }
}

namespace att {
constexpr int VSTR = 192, KB_MAX = 64 * 208, VB = 64 * VSTR, BUFSZ = KB_MAX + VB, BIAS_OFF = 2 * BUFSZ;
struct AU {
    const bf16* q; int qp;
    const bf16 *kA, *vA, *rA; int pA;
    const bf16 *kB, *vB, *rB; int pB;
    const float *kAf, *vAf;
    bf16* o; int op;
    int ntA, nrows, qpos0, h;
};
__device__ __forceinline__ float halves_max(float m) { auto rr = __builtin_amdgcn_permlane32_swap(__float_as_uint(m), __float_as_uint(m), false, false); return fmaxf(__uint_as_float(rr[0]), __uint_as_float(rr[1])); }
__device__ __forceinline__ float halves_sum(float m) { auto rr = __builtin_amdgcn_permlane32_swap(__float_as_uint(m), __float_as_uint(m), false, false); return __uint_as_float(rr[0]) + __uint_as_float(rr[1]); }
__device__ __forceinline__ float partner(float m, int hi) { auto rr = __builtin_amdgcn_permlane32_swap(__float_as_uint(m), __float_as_uint(m), false, false); return hi ? __uint_as_float(rr[0]) : __uint_as_float(rr[1]); }
__device__ __forceinline__ int crow(int r, int hi) { return (r & 3) + 8 * (r >> 2) + 4 * hi; }
#define MFMA32(a, b, c) __builtin_amdgcn_mfma_f32_32x32x16_bf16((a), (b), (c), 0, 0, 0)

struct TL { unsigned long long a[3], b[3]; int sa[3], sb[3], ld[3], c[3]; };
template <int MODE> __device__ __forceinline__ void tile_ctx(const AU& U, int tid, TL& C) {
    constexpr int CPR = MODE == 0 ? 20 : 16, NCH = 64 * CPR, NLD = (NCH + 511) / 512, KC = MODE == 0 ? 12 : 8, KSTR = MODE == 0 ? 208 : 144;
#pragma unroll
    for (int i = 0; i < NLD; ++i) { const int c0 = tid + 512 * i; const int c = c0 < NCH ? c0 : c0 - 512;
        const int row = c / CPR, cc = c % CPR; C.c[i] = c;
        const bool isk = cc < 8, isr = (MODE == 0) && cc >= 8 && cc < 12; const int vo = cc - (MODE == 0 ? 12 : 8);
        const unsigned long long kAa = (unsigned long long)U.kA, vAa = (unsigned long long)U.vA, rAa = (unsigned long long)U.rA, kBa = (unsigned long long)U.kB, vBa = (unsigned long long)U.vB, rBa = (unsigned long long)U.rB;
        const unsigned long long offA = isr ? (unsigned long long)(row * 32 + (cc - 8) * 8) * 2ull : ((unsigned long long)row * (unsigned long long)U.pA + (unsigned long long)((isk ? cc : vo) * 8)) * 2ull;
        const unsigned long long offB = isr ? (unsigned long long)(row * 32 + (cc - 8) * 8) * 2ull : ((unsigned long long)row * (unsigned long long)U.pB + (unsigned long long)((isk ? cc : vo) * 8)) * 2ull;
        C.a[i] = (isk ? kAa : (isr ? rAa : vAa)) + offA; C.b[i] = (isk ? kBa : (isr ? rBa : vBa)) + offB;
        C.sa[i] = (isr ? 64 * 32 : 64 * U.pA) * 2; C.sb[i] = (isr ? 64 * 32 : 64 * U.pB) * 2;
        C.ld[i] = cc < KC ? row * KSTR + cc * 16 : KB_MAX + row * VSTR + (cc - KC) * 16; }
}
template <int MODE> __device__ __forceinline__ void tile_loads(const AU& U, const TL& C, int T, v4u (&pre)[3]) {
    constexpr int CPR = MODE == 0 ? 20 : 16, NCH = 64 * CPR, NLD = (NCH + 511) / 512;
    const bool useA = T < U.ntA;
    if (MODE != 0 && useA && U.kAf) {
#pragma unroll
        for (int i = 0; i < NLD; ++i) { const int row = C.c[i] / CPR, cc = C.c[i] % CPR;
            const float* fs = cc < 8 ? U.kAf + (size_t)(T * 64 + row) * U.pA + cc * 8 : U.vAf + (size_t)(T * 64 + row) * U.pA + (cc - 8) * 8;
            const f32x4 a = *(const f32x4*)fs, b = *(const f32x4*)(fs + 4); v4u o; o.x = pk2(a[0], a[1]); o.y = pk2(a[2], a[3]); o.z = pk2(b[0], b[1]); o.w = pk2(b[2], b[3]); pre[i] = o; }
    } else {
        const int tt = useA ? T : T - U.ntA;
#pragma unroll
        for (int i = 0; i < NLD; ++i) { const unsigned long long src = useA ? C.a[i] + (unsigned long long)tt * (unsigned long long)C.sa[i] : C.b[i] + (unsigned long long)tt * (unsigned long long)C.sb[i]; pre[i] = *(const GAS v4u*)src; }
    }
}
template <int MODE> __device__ __forceinline__ void tile_stores(LAS unsigned char* buf, const TL& C, const v4u (&pre)[3]) {
    constexpr int NLD = ((MODE == 0 ? 20 : 16) * 64 + 511) / 512;
#pragma unroll
    for (int i = 0; i < NLD; ++i) *(LAS v4u*)(buf + C.ld[i]) = pre[i];
}

template <int MODE> __device__ __forceinline__ void st_qk(const LAS unsigned char* buf, int r, int hi, const bf16x8 (&qf)[MODE == 0 ? 6 : 4], const f32x16& negm, f32x16& s0, f32x16& s1) {
    constexpr int NS = MODE == 0 ? 6 : 4, KSTR = MODE == 0 ? 208 : 144;
    const LAS unsigned char* kb = buf + r * KSTR + hi * 16;
#pragma unroll
    for (int s = 0; s < NS; ++s) { const bf16x8 a0 = *(const LAS bf16x8*)(kb + 32 * s), a1 = *(const LAS bf16x8*)(kb + 32 * KSTR + 32 * s);
        if (s == 0) { s0 = MFMA32(a0, qf[0], negm); s1 = MFMA32(a1, qf[0], negm); }
        else { s0 = MFMA32(a0, qf[s], s0); s1 = MFMA32(a1, qf[s], s1); } }
}
template <int MODE> __device__ __forceinline__ void st_sm(int T, int tq, int qpos, int hi, const LAS float* biasl, f32x16& s0, f32x16& s1, f32x16& o0, f32x16& o1, f32x16& negm, float& lrun, bool& fresh) {
    const float c2 = 0.125f * LOG2E;
    if (MODE == 1) {
        if (T + 5 <= tq) { const float cb = biasl[0];
#pragma unroll
            for (int i = 0; i < 16; ++i) { s0[i] = s0[i] * c2 + cb; s1[i] = s1[i] * c2 + cb; } }
        else if (T + 3 >= tq) { const volatile LAS float* bp = biasl + (256 - qpos + T * 64 + 4 * hi);
#pragma unroll
            for (int i = 0; i < 16; ++i) { s0[i] = s0[i] * c2 + bp[(i & 3) + 8 * (i >> 2)]; s1[i] = s1[i] * c2 + bp[(i & 3) + 8 * (i >> 2) + 32]; } }
        else {
#pragma unroll
            for (int i = 0; i < 16; ++i) { const int d0 = qpos - (T * 64 + crow(i, hi)); const int i0 = 256 - min(max(d0, -63), 256), i1 = 256 - min(max(d0 - 32, -63), 256);
                s0[i] = s0[i] * c2 + biasl[i0]; s1[i] = s1[i] * c2 + biasl[i1]; } }
    }
#define MX3_(a, b, c) __builtin_fmaxf(__builtin_fmaxf((a), (b)), (c))
    float ma = MX3_(s0[0], s0[1], s1[0]), mb = MX3_(s0[2], s0[3], s1[1]); ma = MX3_(ma, s1[2], s1[3]);
#pragma unroll
    for (int i = 4; i < 16; i += 4) { ma = MX3_(ma, s0[i], s0[i + 1]); mb = MX3_(mb, s0[i + 2], s0[i + 3]); ma = MX3_(ma, s1[i], s1[i + 1]); mb = MX3_(mb, s1[i + 2], s1[i + 3]); }
#undef MX3_
    float mx = halves_max(__builtin_fmaxf(ma, mb));
    if (fresh || __any(mx > 6.0f)) {
        const float dl = fresh ? mx : fmaxf(mx, 0.f), al = __builtin_amdgcn_exp2f(-dl); lrun *= al; fresh = false;
        const float dn = (MODE == 0) ? dl : dl * (8.0f / LOG2E);
#pragma unroll
        for (int i = 0; i < 16; ++i) { s0[i] -= dl; s1[i] -= dl; o0[i] *= al; o1[i] *= al; negm[i] -= dn; } }
    float sum = 0.f;
#pragma unroll
    for (int i = 0; i < 16; ++i) { s0[i] = __builtin_amdgcn_exp2f(s0[i]); s1[i] = __builtin_amdgcn_exp2f(s1[i]); sum += s0[i] + s1[i]; }
    lrun += sum;
}
__device__ __forceinline__ void st_vread(const LAS unsigned char* buf, int vlane, bf16x8 (&vf)[8]) {
    const LAS unsigned char* vb = buf + KB_MAX + vlane;
#pragma unroll
    for (int ks = 0; ks < 4; ++ks) {
#pragma unroll
        for (int db = 0; db < 2; ++db) {
            const v4i16_t lo = __builtin_amdgcn_ds_read_tr16_b64_v4i16((LAS v4i16_t*)(vb + (16 * ks) * VSTR + db * 64));
            const v4i16_t hh = __builtin_amdgcn_ds_read_tr16_b64_v4i16((LAS v4i16_t*)(vb + (16 * ks + 8) * VSTR + db * 64));
            vf[2 * ks + db] = (bf16x8){lo[0], lo[1], lo[2], lo[3], hh[0], hh[1], hh[2], hh[3]}; } }
}
__device__ __forceinline__ void st_pv(const bf16x8 (&vf)[8], const f32x16& s0, const f32x16& s1, f32x16& o0, f32x16& o1) {
    bf16x8 pf[4];
#pragma unroll
    for (int s = 0; s < 2; ++s) {
        v4u a, b;
        a.x = pk2(s0[8 * s], s0[8 * s + 1]); a.y = pk2(s0[8 * s + 2], s0[8 * s + 3]); a.z = pk2(s0[8 * s + 4], s0[8 * s + 5]); a.w = pk2(s0[8 * s + 6], s0[8 * s + 7]);
        b.x = pk2(s1[8 * s], s1[8 * s + 1]); b.y = pk2(s1[8 * s + 2], s1[8 * s + 3]); b.z = pk2(s1[8 * s + 4], s1[8 * s + 5]); b.w = pk2(s1[8 * s + 6], s1[8 * s + 7]);
        pf[s] = __builtin_bit_cast(bf16x8, a); pf[2 + s] = __builtin_bit_cast(bf16x8, b); }
#pragma unroll
    for (int ks = 0; ks < 4; ++ks) { o0 = MFMA32(vf[2 * ks], pf[ks], o0); o1 = MFMA32(vf[2 * ks + 1], pf[ks], o1); }
}
template <int MODE> __device__ __forceinline__ void attn_unit(const AU& U, LAS unsigned char* lds, const float* rope, const float* biasg) {
    constexpr int NS = MODE == 0 ? 6 : 4;
    int tid = threadIdx.x; asm volatile("" : "+v"(tid));
    const int lane = tid & 63, r = lane & 31, hi = lane >> 5, w = __builtin_amdgcn_readfirstlane(tid >> 6);
    const bool active = 32 * w < U.nrows;
    const int tq = (U.qpos0 + 32 * w) >> 6;
    const int wlo = MODE == 1 ? (tq > 8 ? tq - 8 : 0) : 0, whi = tq;
    const int g0 = U.qpos0 >> 6;
    const int glo = MODE == 1 ? (g0 > 8 ? g0 - 8 : 0) : 0, ghi = (U.qpos0 + U.nrows - 1) >> 6;
    const int qpos = U.qpos0 + 32 * w + r;
    LAS float* biasl = (LAS float*)(lds + BIAS_OFF);
    if (MODE == 1) { for (int i = tid; i < 320; i += 512) biasl[i] = biasg[U.h * 320 + 319 - i] * LOG2E; }
    bf16x8 qf[NS];
    if (active) { const bf16* qrow = U.q + (size_t)(32 * w + r) * U.qp;
#pragma unroll
        for (int s = 0; s < NS; ++s) qf[s] = *(const bf16x8*)(qrow + 16 * s + 8 * hi);
        if (MODE == 0) { const float* rp = rope + (size_t)qpos * 32 + 16 * hi;
#pragma unroll
            for (int j = 0; j < 8; ++j) { const float cs = rp[2 * j], sn = rp[2 * j + 1]; const float x1 = bf1((unsigned short)qf[4][j]), x2 = bf1((unsigned short)qf[5][j]);
                qf[4][j] = (short)f2bf(x1 * cs - x2 * sn); qf[5][j] = (short)f2bf(x2 * cs + x1 * sn); } }
    } else {
#pragma unroll
        for (int s = 0; s < NS; ++s) qf[s] = (bf16x8){0, 0, 0, 0, 0, 0, 0, 0};
    }
    f32x16 o0, o1;
#pragma unroll
    for (int i = 0; i < 16; ++i) { o0[i] = 0.f; o1[i] = 0.f; }
    float lrun = 0.f; bool fresh = true; f32x16 negm;
#pragma unroll
    for (int i = 0; i < 16; ++i) negm[i] = 0.f;
    v4u preA[3], preB[3]; TL C; tile_ctx<MODE>(U, tid, C);
    tile_loads<MODE>(U, C, glo, preA); tile_stores<MODE>(lds, C, preA);
    tile_loads<MODE>(U, C, (glo < ghi ? glo + 1 : ghi), preA);
    __syncthreads();
    int cur = 0;
    const int vlane = (4 * hi + ((lane & 15) >> 2)) * VSTR + ((lane >> 4) & 1) * 32 + (lane & 3) * 8;
#define ATT_ITER(PX, PY) { \
        const bool has_next = T < ghi; \
        tile_loads<MODE>(U, C, (T + 2 < ghi ? T + 2 : ghi), PY);     \
        const LAS unsigned char* buf = lds + cur * BUFSZ; \
        if (active && T >= wlo && T <= whi) { f32x16 s0, s1; bf16x8 vf[8]; st_qk<MODE>(buf, r, hi, qf, negm, s0, s1); st_vread(buf, vlane, vf); st_sm<MODE>(T, tq, qpos, hi, biasl, s0, s1, o0, o1, negm, lrun, fresh); st_pv(vf, s0, s1, o0, o1); } \
        if (has_next) tile_stores<MODE>(lds + (cur ^ 1) * BUFSZ, C, PX); \
        asm volatile("s_waitcnt lgkmcnt(0)" ::: "memory"); __builtin_amdgcn_s_barrier(); asm volatile("" ::: "memory"); \
        if (!has_next) break; \
        cur ^= 1; ++T; }
    for (int T = glo;;) { ATT_ITER(preA, preB); ATT_ITER(preB, preA); }
#undef ATT_ITER
    if (active) {
        const float inv = 1.f / halves_sum(lrun);
        bf16* orow = U.o + (size_t)(32 * w + r) * U.op + 4 * hi;
#pragma unroll
        for (int g = 0; g < 4; ++g) {
            v2u a, b; a.x = pk2(o0[4 * g] * inv, o0[4 * g + 1] * inv); a.y = pk2(o0[4 * g + 2] * inv, o0[4 * g + 3] * inv);
            b.x = pk2(o1[4 * g] * inv, o1[4 * g + 1] * inv); b.y = pk2(o1[4 * g + 2] * inv, o1[4 * g + 3] * inv);
            *(v2u*)(orow + 8 * g) = a; *(v2u*)(orow + 32 + 8 * g) = b; }
    }
    __syncthreads();
}
}


constexpr int SB_HB = 2 * 64 * 144;
template <bool SMP> __device__ __forceinline__ void sb_loads(const bf16* Hb, const float* c_sk, const float* c_sv, int b, int c, int hg, int T, int tid, v4u (&pre)[8]) {
    const bool f32src = SMP && T < 16;
    if (!f32src) { const size_t srow0 = SMP ? (size_t)MP + b * 64 : (size_t)b * SEQ + (size_t)T * 64;
#pragma unroll
        for (int i = 0; i < 8; ++i) { const int ch = tid + 512 * i, row = ch >> 6, cc = ch & 63;
            pre[i] = *(const v4u*)(Hb + (srow0 + row) * IN_C + (cc >= 32 ? 2048 : 1024) + hg * 256 + (cc & 31) * 8); } }
    else {
#pragma unroll
        for (int hf = 0; hf < 2; ++hf) {
#pragma unroll
            for (int i2 = 0; i2 < 4; ++i2) { const int i = hf * 4 + i2; const int ch = tid + 512 * i, row = ch >> 6, cc = ch & 63;
                const float* fs = (cc >= 32 ? c_sv : c_sk) + ((size_t)b * PAST + (size_t)T * 64 + row) * 1024 + hg * 256 + (cc & 31) * 8;
                const f32x4 a = *(const f32x4*)fs, bq = *(const f32x4*)(fs + 4); v4u o; o.x = pk2(a[0], a[1]); o.y = pk2(a[2], a[3]); o.z = pk2(bq[0], bq[1]); o.w = pk2(bq[2], bq[3]); pre[i] = o; }
            asm volatile("" ::: "memory"); } }
}
__device__ __forceinline__ void sb_stores(LAS unsigned char* lds, int tid, const v4u (&pre)[8]) {
#pragma unroll
    for (int i = 0; i < 8; ++i) { const int ch = tid + 512 * i, row = ch >> 6, cc = ch & 63;
        *(LAS v4u*)(lds + ((cc & 31) >> 3) * SB_HB + (cc >= 32 ? 9216 : 0) + row * 144 + (cc & 7) * 16) = pre[i]; }
}
template <bool SMP> __device__ __forceinline__ void sb_unit4(const bf16* Hb, const float* c_sk, const float* c_sv, bf16* O, int b, int c, int hg, LAS unsigned char* lds) {
    using namespace att;
    int tid = threadIdx.x; asm volatile("" : "+v"(tid));
    const int lane = tid & 63, r = lane & 31, hi = lane >> 5, w = __builtin_amdgcn_readfirstlane(tid >> 6), hw = w >> 1, half = w & 1;
    const int tq = SMP ? 16 : c;
    const size_t qrow = (SMP ? (size_t)MP + b * 64 : (size_t)b * SEQ + (size_t)c * 64) + 32 * half + r;
    const int qpos = tq * 64 + 32 * half + r;
    bf16x8 qf[4];
#pragma unroll
    for (int s = 0; s < 4; ++s) qf[s] = *(const bf16x8*)(Hb + qrow * IN_C + (hg * 4 + hw) * 64 + 16 * s + 8 * hi);
    f32x16 o0, o1;
#pragma unroll
    for (int i = 0; i < 16; ++i) { o0[i] = 0.f; o1[i] = 0.f; }
    float carry = 1.f;
    v4u pre[8];
    sb_loads<SMP>(Hb, c_sk, c_sv, b, c, hg, tq, tid, pre);
    LAS unsigned char* hb = lds + hw * SB_HB;
    const int vlane = (4 * hi + ((lane & 15) >> 2)) * 144 + ((lane >> 4) & 1) * 32 + (lane & 3) * 8;
    for (int T = tq;; --T) {
        sb_stores(lds, tid, pre);
        __syncthreads();
        const bool has_next = T > 0;
        if (has_next) sb_loads<SMP>(Hb, c_sk, c_sv, b, c, hg, T - 1, tid, pre);
        {
            const LAS unsigned char* kb = hb + r * 144 + hi * 16;
            f32x16 s0, s1; const f32x16 zero16 = {0.f, 0.f, 0.f, 0.f, 0.f, 0.f, 0.f, 0.f, 0.f, 0.f, 0.f, 0.f, 0.f, 0.f, 0.f, 0.f};
#pragma unroll
            for (int s = 0; s < 4; ++s) { const bf16x8 a0 = *(const LAS bf16x8*)(kb + 32 * s), a1 = *(const LAS bf16x8*)(kb + 32 * 144 + 32 * s);
                if (s == 0) { s0 = MFMA32(a0, qf[0], zero16); s1 = MFMA32(a1, qf[0], zero16); } else { s0 = MFMA32(a0, qf[s], s0); s1 = MFMA32(a1, qf[s], s1); } }
            bf16x8 vf[8];
            { const LAS unsigned char* vb = hb + 9216 + vlane;
#pragma unroll
              for (int ks = 0; ks < 4; ++ks) {
#pragma unroll
                for (int db = 0; db < 2; ++db) {
                    const v4i16_t lo = __builtin_amdgcn_ds_read_tr16_b64_v4i16((LAS v4i16_t*)(vb + (16 * ks) * 144 + db * 64));
                    const v4i16_t hh = __builtin_amdgcn_ds_read_tr16_b64_v4i16((LAS v4i16_t*)(vb + (16 * ks + 8) * 144 + db * 64));
                    vf[2 * ks + db] = (bf16x8){lo[0], lo[1], lo[2], lo[3], hh[0], hh[1], hh[2], hh[3]}; } } }
            f32x16 U0, U1;
#pragma unroll
            for (int i = 0; i < 16; ++i) {
                const float e0 = __builtin_amdgcn_exp2f(s0[i]), e1 = __builtin_amdgcn_exp2f(s1[i]);
                U0[i] = __builtin_amdgcn_rcpf(1.f + e0); U1[i] = __builtin_amdgcn_rcpf(1.f + e1);
                s0[i] = 1.f - U0[i]; s1[i] = 1.f - U1[i]; }
            if (T == tq) {
#pragma unroll
                for (int i = 0; i < 16; ++i) { const int kv = T * 64 + crow(i, hi);
                    if (kv >= qpos) { U0[i] = 1.f; s0[i] = 0.f; } if (kv + 32 >= qpos) { U1[i] = 1.f; s1[i] = 0.f; } } }
            float R = carry;
#pragma unroll
            for (int bg = 7; bg >= 0; --bg) { const int g = bg & 3;
                if (bg >= 4) { const float gs = (U1[4 * g] * U1[4 * g + 1]) * (U1[4 * g + 2] * U1[4 * g + 3]); const float gp = partner(gs, hi);
                    const float t3 = hi ? R : R * gp, t2 = t3 * U1[4 * g + 3], t1 = t2 * U1[4 * g + 2], t0 = t1 * U1[4 * g + 1];
                    s1[4 * g + 3] *= t3; s1[4 * g + 2] *= t2; s1[4 * g + 1] *= t1; s1[4 * g] *= t0; R *= gs * gp; }
                else { const float gs = (U0[4 * g] * U0[4 * g + 1]) * (U0[4 * g + 2] * U0[4 * g + 3]); const float gp = partner(gs, hi);
                    const float t3 = hi ? R : R * gp, t2 = t3 * U0[4 * g + 3], t1 = t2 * U0[4 * g + 2], t0 = t1 * U0[4 * g + 1];
                    s0[4 * g + 3] *= t3; s0[4 * g + 2] *= t2; s0[4 * g + 1] *= t1; s0[4 * g] *= t0; R *= gs * gp; }
            }
            carry = R;
            bf16x8 pf[4];
#pragma unroll
            for (int s = 0; s < 2; ++s) {
                v4u a, bq;
                a.x = pk2(s0[8 * s], s0[8 * s + 1]); a.y = pk2(s0[8 * s + 2], s0[8 * s + 3]); a.z = pk2(s0[8 * s + 4], s0[8 * s + 5]); a.w = pk2(s0[8 * s + 6], s0[8 * s + 7]);
                bq.x = pk2(s1[8 * s], s1[8 * s + 1]); bq.y = pk2(s1[8 * s + 2], s1[8 * s + 3]); bq.z = pk2(s1[8 * s + 4], s1[8 * s + 5]); bq.w = pk2(s1[8 * s + 6], s1[8 * s + 7]);
                pf[s] = __builtin_bit_cast(bf16x8, a); pf[2 + s] = __builtin_bit_cast(bf16x8, bq); }
#pragma unroll
            for (int ks = 0; ks < 4; ++ks) { o0 = MFMA32(vf[2 * ks], pf[ks], o0); o1 = MFMA32(vf[2 * ks + 1], pf[ks], o1); }
        }
        const int done = __all(carry == 0.f);
        if (__syncthreads_and(done) || !has_next) break;
    }
    bf16* orow = O + qrow * 1024 + (hg * 4 + hw) * 64 + 4 * hi;
#pragma unroll
    for (int g = 0; g < 4; ++g) {
        v2u a, bq; a.x = pk2(o0[4 * g], o0[4 * g + 1]); a.y = pk2(o0[4 * g + 2], o0[4 * g + 3]);
        bq.x = pk2(o1[4 * g], o1[4 * g + 1]); bq.y = pk2(o1[4 * g + 2], o1[4 * g + 3]);
        *(v2u*)(orow + 8 * g) = a; *(v2u*)(orow + 32 + 8 * g) = bq; }
    __syncthreads();
}

#define XB_TMO      128
#define XB_XCNT(j)  (256  + 64 * (j))
#define XB_XSUB(j)  (1280 + 64 * (j))
#define XB_XGEN(j)  (2304 + 64 * (j))
#define XB_TOP      3328
#define XB_TOPGEN   3392
#define XCD_BAR_WORDS 3456
#define XB_SPIN_CAP (1u << 18)

__device__ __forceinline__ unsigned xb_ld(unsigned* p)              { return __hip_atomic_load(p, __ATOMIC_RELAXED, __HIP_MEMORY_SCOPE_AGENT); }
__device__ __forceinline__ unsigned xb_add(unsigned* p, unsigned v) { return __hip_atomic_fetch_add(p, v, __ATOMIC_RELAXED, __HIP_MEMORY_SCOPE_AGENT); }
__device__ __forceinline__ unsigned xb_xcc_id() { return (unsigned)__builtin_amdgcn_s_getreg((3 << 11) | 20) & 0xFu; }
#define XB_SPIN(cond, bar) do { unsigned _sp = 0; while (cond) { __builtin_amdgcn_s_sleep(1); \
    if ((++_sp & 255u) == 0u) { if (xb_ld(&(bar)[XB_TMO])) break; if (_sp > XB_SPIN_CAP) { atomicAdd(&(bar)[XB_TMO], 1u); break; } } } } while (0)

struct XcdBarrier {
    unsigned* bar; unsigned x;
    volatile LAS unsigned* st;
};

__device__ __forceinline__ XcdBarrier xcd_barrier_post(unsigned* bar, volatile LAS unsigned* st) {
    XcdBarrier b; b.bar = bar; b.x = xb_xcc_id(); b.st = st;
    if (threadIdx.x == 0) (void)xb_add(&bar[XB_XCNT(b.x)], 1u);
    return b;
}
__device__ __forceinline__ void xcd_barrier_complete(unsigned* bar, unsigned x, unsigned& nloc, unsigned& nx) {
    const unsigned G = gridDim.x * gridDim.y * gridDim.z;
    unsigned sum, cnt, mine, sp = 0u;
    for (;;) {
        sum = 0u; cnt = 0u; mine = 0u;
#pragma unroll
        for (unsigned j = 0; j < 16; ++j) { const unsigned c = xb_ld(&bar[XB_XCNT(j)]); sum += c; cnt += (c > 0u) ? 1u : 0u; mine = (j == x) ? c : mine; }
        if (sum == G) break;
        __builtin_amdgcn_s_sleep(1);
        if ((++sp & 255u) == 0u) { if (xb_ld(&bar[XB_TMO])) break; if (sp > XB_SPIN_CAP) { atomicAdd(&bar[XB_TMO], 1u); break; } }
    }
    nloc = mine > 0u ? mine : 1u; nx = cnt > 0u ? cnt : 1u;
}

__device__ __forceinline__ void xcd_barrier(const XcdBarrier& b) {
    asm volatile("s_waitcnt vmcnt(0)" ::: "memory");
    __syncthreads();
    if (threadIdx.x == 0) {
        unsigned* bar = b.bar;
        __builtin_amdgcn_s_waitcnt(0);
        unsigned nloc = b.st[0], nx = b.st[1];
        if (nloc == 0u) { xcd_barrier_complete(bar, b.x, nloc, nx); b.st[0] = nloc; b.st[1] = nx; }
        const unsigned old = xb_add(&bar[XB_XSUB(b.x)], 1u);
        const unsigned gen = old / nloc;
        if (old + 1u == (gen + 1u) * nloc) {
            __builtin_amdgcn_fence(__ATOMIC_RELEASE, "agent");
            asm volatile("s_waitcnt vmcnt(0)" ::: "memory");
            const unsigned og = xb_add(&bar[XB_TOP], 1u);
            const unsigned tg = og / nx;
            if (og + 1u == (tg + 1u) * nx) xb_add(&bar[XB_TOPGEN], 1u);
            else XB_SPIN(xb_ld(&bar[XB_TOPGEN]) == tg, bar);
            __builtin_amdgcn_fence(__ATOMIC_ACQUIRE, "agent");
            xb_add(&bar[XB_XGEN(b.x)], 1u);
            asm volatile("s_waitcnt vmcnt(0)" ::: "memory");
        } else {
            XB_SPIN(xb_ld(&bar[XB_XGEN(b.x)]) == gen, bar);
            __builtin_amdgcn_fence(__ATOMIC_ACQUIRE, "agent");
            asm volatile("s_waitcnt vmcnt(0)" ::: "memory");
        }
    }
    __syncthreads();
}

#ifndef PROBE_P4
#define PROBE_P4 1
#endif
#ifndef PROBE_P11
#define PROBE_P11 1
#endif
#ifndef PROBE_SYNC
#define PROBE_SYNC 1
#endif
constexpr int NPH = 17;
__global__ void __launch_bounds__(512, 2) fwd(Args args) {
    extern __shared__ __attribute__((aligned(16))) unsigned char lds_raw[];
    LAS unsigned char* lds = (LAS unsigned char*)lds_raw;
    const int tid = threadIdx.x, lane = tid & 63, wave = __builtin_amdgcn_readfirstlane(tid >> 6);
    const int G = gridDim.x, bx = blockIdx.x;
    const int gw = bx * 8 + wave, NGW = G * 8;
    const size_t gt = (size_t)bx * 512 + tid, gn = (size_t)G * 512;
    unsigned char* ws = args.ws; float* out = args.out;
    const float *x_p = args.in[0], *x_s = args.in[1], *c_ckv = args.in[2], *c_kr = args.in[3], *c_bk = args.in[4], *c_bv = args.in[5], *c_sk = args.in[6], *c_sv = args.in[7];
    const float *w_in_ab = args.in[8], *g_q = args.in[9], *w_uq = args.in[10], *g_kv = args.in[11], *w_ukv = args.in[12], *rel_bias = args.in[13], *w_out_ab = args.in[14];
    const float *w_in_c = args.in[15], *w_out_c = args.in[16], *ln_mix_g = args.in[17], *ln_mix_b = args.in[18], *ln_ffn_g = args.in[19], *ln_ffn_b = args.in[20], *w_up = args.in[21], *w_down = args.in[22];
    bf16 *Wt_inab = (bf16*)(ws + W_INAB), *Wt_uq = (bf16*)(ws + W_UQ), *Wt_ukv = (bf16*)(ws + W_UKV), *Wt_outab = (bf16*)(ws + W_OUTAB), *Wt_inc = (bf16*)(ws + W_INC), *Wt_outc = (bf16*)(ws + W_OUTC);
    bf16 *Wt_up = (bf16*)(ws + W_UP), *Wt_down = (bf16*)(ws + W_DOWN);
    float* rope = (float*)(ws + W_ROPE);
    bf16 *Xb = (bf16*)(ws + W_XB), *Hb = (bf16*)(ws + W_H), *KVb = (bf16*)(ws + W_KV), *Ub = (bf16*)(ws + W_H), *Ob = Xb;
    unsigned char* ob = (unsigned char*)out;
    bf16 *QLb = (bf16*)(ob + S_QL), *QAb = (bf16*)(ob + S_QA), *CKVb = (bf16*)(ob + S_CKV), *KRb = (bf16*)(ob + S_KR), *cbk = (bf16*)(ob + S_CBK), *cbv = (bf16*)(ob + S_CBV);
    float* YF = out + O_Y; float* PARTb = (float*)(ws + W_PART); bf16* XH = (bf16*)(ws + W_XH); bf16* O1b = (bf16*)(ws + W_KV);
    cg::grid_group grid = cg::this_grid();
    const int lo = args.ph_lo, hi = args.ph_hi;
    volatile LAS unsigned* MISC = (volatile LAS unsigned*)(lds + 131072 + 320);
    if (tid < 32) MISC[tid] = 0u;
    __syncthreads();
    XcdBarrier xbar = xcd_barrier_post((unsigned*)(ws + 16384), MISC + 8);
    if (lo < 0) grid.sync();
#define IN(k) (lo <= (k) && (k) < hi)
#define SEAM(k) do { if (IN(k) && IN((k) + 1)) { for (int s_ = 0; s_ < PROBE_SYNC; ++s_) xcd_barrier(xbar); } } while (0)

    if (IN(0)) {
        LAS float* scr = (LAS float*)(lds + wave * 16384);
        constexpr int I0 = (DM / 64) * (IN_AB / 32), I1 = (768 / 64) * (768 / 32), I2 = (256 / 64) * (1024 / 32), I3 = (DM / 64) * (DM / 32), I4 = (DM / 64) * (IN_C / 32), I5 = I3,
                      I6 = (DM / 64) * (FF / 32), I7 = (FF / 64) * (DM / 32);
        constexpr int NIT = I0 + I1 + I2 + I3 + I4 + I5 + 2 * I6 + 2 * I7;
        for (int it = gw; it < NIT; it += NGW) { int r_ = it;
            if (r_ < I0) { transpose_item(w_in_ab, DM, IN_AB, Wt_inab, scr, r_, lane); continue; } r_ -= I0;
            if (r_ < I1) { transpose_item(w_uq, 768, 768, Wt_uq, scr, r_, lane, 0.10206207261596575f * LOG2E); continue; } r_ -= I1;
            if (r_ < I2) { transpose_item(w_ukv, 256, 1024, Wt_ukv, scr, r_, lane); continue; } r_ -= I2;
            if (r_ < I3) { transpose_item(w_out_ab, DM, DM, Wt_outab, scr, r_, lane); continue; } r_ -= I3;
            if (r_ < I4) { transpose_item(w_in_c, DM, IN_C, Wt_inc, scr, r_, lane, 0.125f * LOG2E, 1024); continue; } r_ -= I4;
            if (r_ < I5) { transpose_item(w_out_c, DM, DM, Wt_outc, scr, r_, lane); continue; } r_ -= I5;
            if (r_ < 2 * I6) { const int l = r_ / I6; transpose_item(w_up + (size_t)l * DM * FF, DM, FF, Wt_up + (size_t)l * DM * FF, scr, r_ % I6, lane); continue; } r_ -= 2 * I6;
            { const int l = r_ / I7; transpose_item(w_down + (size_t)l * DM * FF, FF, DM, Wt_down + (size_t)l * DM * FF, scr, r_ % I7, lane); }
        }
        for (size_t i = gt; i < (size_t)(IN_ABP - IN_AB) * DM / 8; i += gn) *(v4u*)(Wt_inab + (size_t)IN_AB * DM + i * 8) = (v4u){0u, 0u, 0u, 0u};
        cvt_rows(x_p, Xb, (size_t)MP * DM / 8, gt, gn);
        cvt_rows(x_s, Xb + (size_t)MP * DM, (size_t)MS * DM / 8, gt, gn);
        cvt_rows(c_ckv, CKVb + (size_t)M * 256, (size_t)DB * PAST * 256 / 8, gt, gn);
        cvt_rows(c_kr, KRb + (size_t)M * 32, (size_t)DB * PAST * 32 / 8, gt, gn);
        for (size_t i = gt; i < (size_t)SEQ * 16; i += gn) { const int pos = (int)(i >> 4), k = (int)(i & 15);
            const float inv = k == 0 ? 1.000000000e+00f : k == 1 ? 5.623413324e-01f : k == 2 ? 3.162277639e-01f : k == 3 ? 1.778279394e-01f : k == 4 ? 1.000000015e-01f : k == 5 ? 5.623413250e-02f : k == 6 ? 3.162277490e-02f : k == 7 ? 1.778279431e-02f :
                              k == 8 ? 9.999999776e-03f : k == 9 ? 5.623413250e-03f : k == 10 ? 3.162277630e-03f : k == 11 ? 1.778279431e-03f : k == 12 ? 1.000000047e-03f : k == 13 ? 5.623413017e-04f : k == 14 ? 3.162277571e-04f : 1.778279402e-04f;
            const float ang = (float)pos * inv; double tr = (double)ang * 0.15915494309189535; tr -= __builtin_floor(tr); const float fr = (float)tr;
            rope[i * 2] = __builtin_amdgcn_cosf(fr); rope[i * 2 + 1] = __builtin_amdgcn_sinf(fr); }
    }
    SEAM(0);
    if (IN(1)) { pg8::Gemm g{Xb, Wt_inab, M, IN_ABP, DM, DM}; pg8::StaticOrder S; S.init(M, IN_ABP, G, bx); pg8::EpiBf16<0> E{Hb, IN_ABP};
        pg8::gemm_phase<pg8::EpiBf16<0>, pg8::StaticOrder, true, true>(lds, g, S, E); }
    SEAM(1);
    if (IN(2)) {
#define P2_LOAD(S, m) \
        const bool ok##S = (m) < M; const int mm##S = ok##S ? (m) : 0; const bf16* hrow##S = Hb + (size_t)mm##S * IN_ABP; \
        const bool isp##S = mm##S < MP; const int ms##S = mm##S - MP; const int pos##S = isp##S ? (mm##S & (SEQ - 1)) : PAST + (ms##S & 63); \
        v2u vq##S[3]; _Pragma("unroll") for (int j = 0; j < 3; ++j) vq##S[j] = *(const v2u*)(hrow##S + lane * 4 + 256 * j); \
        const v2u vc##S = *(const v2u*)(hrow##S + 768 + lane * 4); \
        const unsigned short xr1##S = hrow##S[1024 + (lane & 15)], xr2##S = hrow##S[1040 + (lane & 15)]; \
        const float cs##S = rope[(size_t)pos##S * 32 + 2 * (lane & 15)], sn##S = rope[(size_t)pos##S * 32 + 2 * (lane & 15) + 1]; \
        float *dk##S = nullptr, *dv##S = nullptr; \
        if (isp##S) { const int t = mm##S & (SEQ - 1), b = mm##S >> 12; if (t >= SEQ - 512) { dk##S = out + O_BKP + ((size_t)b * 512 + t - (SEQ - 512)) * 512; dv##S = out + O_BVP + ((size_t)b * 512 + t - (SEQ - 512)) * 512; } } \
        else { const int b = ms##S >> 6, t = ms##S & 63; dk##S = out + O_BKS + ((size_t)b * 512 + 448 + t) * 512; dv##S = out + O_BVS + ((size_t)b * 512 + 448 + t) * 512; } \
        v4u kq##S = (v4u){0u, 0u, 0u, 0u}, vv##S = (v4u){0u, 0u, 0u, 0u}; if (dk##S) { kq##S = *(const v4u*)(hrow##S + 1568 + lane * 8); vv##S = *(const v4u*)(hrow##S + 2080 + lane * 8); }
#define P2_FIN(S) if (ok##S) { \
        { float f[12]; float ss = 0.f; \
            _Pragma("unroll") for (int j = 0; j < 3; ++j) { f[4 * j] = bflo(vq##S[j].x); f[4 * j + 1] = bfhi(vq##S[j].x); f[4 * j + 2] = bflo(vq##S[j].y); f[4 * j + 3] = bfhi(vq##S[j].y); } \
            _Pragma("unroll") for (int j = 0; j < 12; ++j) ss += f[j] * f[j]; \
            ss = wave_sum(ss); const float rs = rsqrtf(ss * (1.f / 768.f) + 1e-6f); \
            _Pragma("unroll") for (int j = 0; j < 3; ++j) { const f32x4 gv = *(const f32x4*)(g_q + lane * 4 + 256 * j); v2u o; o.x = pk2(f[4 * j] * rs * gv[0], f[4 * j + 1] * rs * gv[1]); o.y = pk2(f[4 * j + 2] * rs * gv[2], f[4 * j + 3] * rs * gv[3]); \
                *(v2u*)(QLb + (size_t)mm##S * 768 + lane * 4 + 256 * j) = o; } } \
        { const float a = bflo(vc##S.x), b = bfhi(vc##S.x), c = bflo(vc##S.y), d = bfhi(vc##S.y); \
            float ss = a * a + b * b + c * c + d * d; ss = wave_sum(ss); const float rs = rsqrtf(ss * (1.f / 256.f) + 1e-6f); \
            const f32x4 gv = *(const f32x4*)(g_kv + lane * 4); const f32x4 y = (f32x4){a * rs * gv[0], b * rs * gv[1], c * rs * gv[2], d * rs * gv[3]}; \
            float* dst = isp##S ? out + O_CKVP + (size_t)mm##S * 256 : out + O_CKVS + (size_t)ms##S * 256; *(f32x4*)(dst + lane * 4) = y; \
            v2u o; o.x = pk2(y[0], y[1]); o.y = pk2(y[2], y[3]); *(v2u*)(CKVb + (size_t)mm##S * 256 + lane * 4) = o; } \
        if (lane < 16) { const float x1 = bf1(xr1##S), x2 = bf1(xr2##S); \
            const float y1 = x1 * cs##S - x2 * sn##S, y2 = x2 * cs##S + x1 * sn##S; float* dst = isp##S ? out + O_KRP + (size_t)mm##S * 32 : out + O_KRS + (size_t)ms##S * 32; dst[lane] = y1; dst[lane + 16] = y2; \
            KRb[(size_t)mm##S * 32 + lane] = (bf16)f2bf(y1); KRb[(size_t)mm##S * 32 + 16 + lane] = (bf16)f2bf(y2); } \
        if (dk##S) { \
            *(f32x4*)(dk##S + lane * 8) = (f32x4){bflo(kq##S.x), bfhi(kq##S.x), bflo(kq##S.y), bfhi(kq##S.y)}; *(f32x4*)(dk##S + lane * 8 + 4) = (f32x4){bflo(kq##S.z), bfhi(kq##S.z), bflo(kq##S.w), bfhi(kq##S.w)}; \
            *(f32x4*)(dv##S + lane * 8) = (f32x4){bflo(vv##S.x), bfhi(vv##S.x), bflo(vv##S.y), bfhi(vv##S.y)}; *(f32x4*)(dv##S + lane * 8 + 4) = (f32x4){bflo(vv##S.z), bfhi(vv##S.z), bflo(vv##S.w), bfhi(vv##S.w)}; } }
        for (int m = gw; m < M; m += 4 * NGW) {
            P2_LOAD(A, m) P2_LOAD(B, m + NGW) P2_LOAD(C, m + 2 * NGW) P2_LOAD(D, m + 3 * NGW)
            P2_FIN(A) P2_FIN(B) P2_FIN(C) P2_FIN(D)
        }
#undef P2_LOAD
#undef P2_FIN
    }
    SEAM(2);
    if (IN(3)) {
        { pg8::Gemm g{QLb, Wt_uq, M, 768, 768, 768}; pg8::StaticOrder S; S.init(M, 768, G, bx); pg8::EpiBf16<0> E{QAb, 768};
          pg8::gemm_phase<pg8::EpiBf16<0>, pg8::StaticOrder, true, true>(lds, g, S, E); }
        { pg8::Gemm g{CKVb, Wt_ukv, MKV, 1024, 256, 256}; pg8::StaticOrder S; S.init(MKV, 1024, G, G - 1 - bx); pg8::EpiBf16<0> E{KVb, 1024};
          pg8::gemm_phase<pg8::EpiBf16<0>, pg8::StaticOrder, true, true>(lds, g, S, E); }
    }
    SEAM(3);
    for (int rep_ = 0; rep_ < PROBE_P4; ++rep_) if (IN(4)) {
        constexpr int NU = 2560;
        for (int rd = 0; rd * G < NU; ++rd) { const int i = rd * G + ((rd & 1) ? (G - 1 - bx) : bx); if (i >= NU) continue;
            att::AU U; U.kAf = nullptr; U.vAf = nullptr;
            if (i < 1024) { const int qb = 15 - (i >> 6), bh = i & 63, b = bh >> 3, h = bh & 7; const size_t r0 = (size_t)b * SEQ, rq = r0 + qb * 256;
                U.q = QAb + rq * 768 + h * 96; U.qp = 768; U.kA = KVb + r0 * 1024 + h * 128; U.vA = U.kA + 64; U.rA = KRb + r0 * 32; U.pA = 1024; U.kB = U.kA; U.vB = U.vA; U.rB = U.rA; U.pB = 1024;
                U.o = Ob + rq * 1024 + h * 64; U.op = 1024; U.ntA = 1 << 30; U.nrows = 256; U.qpos0 = qb * 256; U.h = h;
                att::attn_unit<0>(U, lds, rope, rel_bias); }
            else if (i < 2048) { const int j = i - 1024, qb = 15 - (j >> 6), bh = j & 63, b = bh >> 3, h = bh & 7; const size_t r0 = (size_t)b * SEQ, rq = r0 + qb * 256;
                U.q = Hb + rq * IN_ABP + 1056 + h * 64; U.qp = IN_ABP; U.kA = Hb + r0 * IN_ABP + 1568 + h * 64; U.vA = Hb + r0 * IN_ABP + 2080 + h * 64; U.rA = nullptr; U.pA = IN_ABP; U.kB = U.kA; U.vB = U.vA; U.rB = nullptr; U.pB = IN_ABP;
                U.o = Ob + rq * 1024 + 512 + h * 64; U.op = 1024; U.ntA = 1 << 30; U.nrows = 256; U.qpos0 = qb * 256; U.h = h;
                att::attn_unit<1>(U, lds, rope, rel_bias); }
            else if (i < 2304) { const int j = i - 2048, b = j >> 3, h = j & 7; const size_t rn = (size_t)MP + b * 64, rc = (size_t)M + (size_t)b * PAST;
                U.q = QAb + rn * 768 + h * 96; U.qp = 768; U.kA = KVb + rc * 1024 + h * 128; U.vA = U.kA + 64; U.rA = KRb + rc * 32; U.pA = 1024;
                U.kB = KVb + rn * 1024 + h * 128; U.vB = U.kB + 64; U.rB = KRb + rn * 32; U.pB = 1024;
                U.o = Ob + rn * 1024 + h * 64; U.op = 1024; U.ntA = 16; U.nrows = 64; U.qpos0 = PAST; U.h = h;
                att::attn_unit<0>(U, lds, rope, rel_bias); }
            else { const int j = i - 2304, b = j >> 3, h = j & 7; const size_t rn = (size_t)MP + b * 64;
                U.q = Hb + rn * IN_ABP + 1056 + h * 64; U.qp = IN_ABP; U.kA = nullptr; U.vA = nullptr; U.kAf = c_bk + (size_t)b * 512 * 512 + h * 64; U.vAf = c_bv + (size_t)b * 512 * 512 + h * 64; U.rA = nullptr; U.pA = 512;
                U.kB = Hb + rn * IN_ABP + 1568 + h * 64; U.vB = Hb + rn * IN_ABP + 2080 + h * 64; U.rB = nullptr; U.pB = IN_ABP;
                U.o = Ob + rn * 1024 + 512 + h * 64; U.op = 1024; U.ntA = 8; U.nrows = 64; U.qpos0 = 512; U.h = h;
                att::attn_unit<1>(U, lds, rope, rel_bias); }
        }
    }
    SEAM(4);
    if (IN(5)) { { pg8::Gemm g{Ob, Wt_outab, MP, DM, 1024, 1024}; pg8::StaticOrder S; S.init(MP, DM, G, bx); pg8::EpiResH<true> E{x_p, XH, DM, ALPHA};
          pg8::gemm_phase<pg8::EpiResH<true>, pg8::StaticOrder, true, true>(lds, g, S, E); }
        { pg8::Gemm g{Ob, Wt_outab, M, DM, 256, 1024}; pg8::SplitOrder S{MP / 256, DM / 256, 4, 256, 128, bx, G}; pg8::EpiPart E{PARTb, MP / 256, 256, MS, DM};
          pg8::gemm_phase<pg8::EpiPart, pg8::SplitOrder, true, true>(lds, g, S, E); } }
    SEAM(5);
#define LN_LOAD(v, m) do { if ((m) < MP) { _Pragma("unroll") for (int j = 0; j < 4; ++j) { const v2u q_ = *(const v2u*)(XH + (size_t)(m) * DM + lane * 4 + 256 * j); v[j] = (f32x4){bflo(q_.x), bfhi(q_.x), bflo(q_.y), bfhi(q_.y)}; } } \
        else if ((m) < M) { const size_t r_ = (size_t)((m) - MP); \
            if (RSF_) { _Pragma("unroll") for (int j = 0; j < 4; ++j) v[j] = *(const f32x4*)((RSF_) + r_ * DM + lane * 4 + 256 * j) * ALPHA; } \
            else { _Pragma("unroll") for (int j = 0; j < 4; ++j) { const v2u q_ = *(const v2u*)(Xb + (size_t)(m) * DM + lane * 4 + 256 * j); v[j] = (f32x4){bflo(q_.x), bfhi(q_.x), bflo(q_.y), bfhi(q_.y)} * ALPHA; } } \
            for (int ks = 0; ks < NSP_; ++ks) { const float* pp = PARTb + ((size_t)ks * MS + r_) * DM; _Pragma("unroll") for (int j = 0; j < 4; ++j) v[j] += *(const f32x4*)(pp + lane * 4 + 256 * j); } } \
        else { _Pragma("unroll") for (int j = 0; j < 4; ++j) v[j] = (f32x4){0.f, 0.f, 0.f, 0.f}; } } while (0)
#define LN_FINISH(v, m, gam, bet, FIN) do { float s = 0.f, s2 = 0.f; \
        _Pragma("unroll") for (int j = 0; j < 4; ++j) { s += (v[j][0] + v[j][1]) + (v[j][2] + v[j][3]); s2 += (v[j][0] * v[j][0] + v[j][1] * v[j][1]) + (v[j][2] * v[j][2] + v[j][3] * v[j][3]); } \
        const float mean = wave_sum(s) * (1.f / DM); const float var = fmaxf(wave_sum(s2) * (1.f / DM) - mean * mean, 0.f);     \
        _Pragma("unroll") for (int j = 0; j < 4; ++j) v[j] = v[j] - mean; \
        const float rstd = rsqrtf(var + 1e-5f); \
        if ((m) < M) { _Pragma("unroll") for (int j = 0; j < 4; ++j) { const f32x4 gv = *(const f32x4*)((gam) + lane * 4 + 256 * j), bv = *(const f32x4*)((bet) + lane * 4 + 256 * j); \
            const f32x4 y = v[j] * rstd * gv + bv; \
            if (FIN) __builtin_nontemporal_store(y, (f32x4*)(YF + (size_t)(m) * DM + lane * 4 + 256 * j)); \
            else { v2u o; o.x = pk2(y[0], y[1]); o.y = pk2(y[2], y[3]); *(v2u*)(Xb + (size_t)(m) * DM + lane * 4 + 256 * j) = o; } } } } while (0)
#define LN_PHASE(gam, bet, RSF, NS_, FIN) do { const float* RSF_ = (RSF); const int NSP_ = (NS_); \
        for (int m = gw; m < M; m += 4 * NGW) { const int mb = m + NGW, mc = m + 2 * NGW, md = m + 3 * NGW; f32x4 va[4], vb[4], vc[4], vd[4]; LN_LOAD(va, m); LN_LOAD(vb, mb); LN_LOAD(vc, mc); LN_LOAD(vd, md); \
            LN_FINISH(va, m, gam, bet, FIN); LN_FINISH(vb, mb, gam, bet, FIN); LN_FINISH(vc, mc, gam, bet, FIN); LN_FINISH(vd, md, gam, bet, FIN); } } while (0)
    if (IN(6)) LN_PHASE(ln_mix_g, ln_mix_b, x_s, 4, false);
    SEAM(6);
    if (IN(7)) { pg8::Gemm g{Xb, Wt_up, M, FF, DM, DM}; pg8::StaticOrder S; S.init(M, FF, G, bx); pg8::EpiBf16<2> E{Ub, FF};
        pg8::gemm_phase<pg8::EpiBf16<2>, pg8::StaticOrder, true, true>(lds, g, S, E); }
    SEAM(7);
    if (IN(8)) { { pg8::Gemm g{Ub, Wt_down, MP, DM, 4096, 4096}; pg8::StaticOrder S; S.init(MP, DM, G, bx); pg8::EpiResH<false> E{Xb, XH, DM, ALPHA};
          pg8::gemm_phase<pg8::EpiResH<false>, pg8::StaticOrder, true, true>(lds, g, S, E); }
        { pg8::Gemm g{Ub, Wt_down, M, DM, 512, 4096}; pg8::SplitOrder S{MP / 256, DM / 256, 8, 512, 256, bx, G}; pg8::EpiPart E{PARTb, MP / 256, 512, MS, DM};
          pg8::gemm_phase<pg8::EpiPart, pg8::SplitOrder, true, true>(lds, g, S, E); } }
    SEAM(8);
    if (IN(9)) { LN_PHASE(ln_ffn_g, ln_ffn_b, (const float*)nullptr, 8, false); }
    SEAM(9);
    if (IN(10)) { pg8::Gemm g{Xb, Wt_inc, M, IN_C, DM, DM}; pg8::StaticOrder S; S.init(M, IN_C, G, bx); typedef pg8::EpiQKV<O_SKP, O_SVP, O_SKS, O_SVS, MP, IN_C> EQ; EQ E{Hb, out};
        pg8::gemm_phase<EQ, pg8::StaticOrder, true, true>(lds, g, S, E);
        { const bool part = (G == 256); if (!part || bx >= 96) { const size_t gtx = part ? (size_t)(bx - 96) * 512 + tid : gt, gnx = part ? (size_t)160 * 512 : gn;
        for (size_t i = gtx; i < (size_t)DB * 448 * 128; i += gnx) { const size_t b = i / (448 * 128), rem = i % (448 * 128);
            __builtin_nontemporal_store(__builtin_nontemporal_load((const f32x4*)(c_bk + b * 512 * 512 + 64 * 512 + rem * 4)), (f32x4*)(out + O_BKS + b * 512 * 512 + rem * 4));
            __builtin_nontemporal_store(__builtin_nontemporal_load((const f32x4*)(c_bv + b * 512 * 512 + 64 * 512 + rem * 4)), (f32x4*)(out + O_BVS + b * 512 * 512 + rem * 4)); }
        } } }
    SEAM(10);
    for (int rep_ = 0; rep_ < PROBE_P11; ++rep_) if (IN(11)) {
        constexpr int NU = 2048 + 128;
        for (int i = bx; i < NU; i += G) {
            if (i < 2048) sb_unit4<false>(Hb, c_sk, c_sv, O1b, i >> 8, (i >> 2) & 63, i & 3, lds);
            else { const int j = i - 2048; sb_unit4<true>(Hb, c_sk, c_sv, O1b, j >> 2, 0, j & 3, lds); }
        }
    }
    SEAM(11);
    if (IN(12)) { { pg8::Gemm g{O1b, Wt_outc, MP, DM, 1024, 1024}; pg8::StaticOrder S; S.init(MP, DM, G, bx); pg8::EpiResH<false> E{Xb, XH, DM, ALPHA};
          pg8::gemm_phase<pg8::EpiResH<false>, pg8::StaticOrder, true, true>(lds, g, S, E); }
        { pg8::Gemm g{O1b, Wt_outc, M, DM, 256, 1024}; pg8::SplitOrder S{MP / 256, DM / 256, 4, 256, 128, bx, G}; pg8::EpiPart E{PARTb, MP / 256, 256, MS, DM};
          pg8::gemm_phase<pg8::EpiPart, pg8::SplitOrder, true, true>(lds, g, S, E); } }
    SEAM(12);
    if (IN(13)) LN_PHASE(ln_mix_g + DM, ln_mix_b + DM, (const float*)nullptr, 4, false);
    SEAM(13);
    if (IN(14)) { pg8::Gemm g{Xb, Wt_up + (size_t)DM * FF, M, FF, DM, DM}; pg8::StaticOrder S; S.init(M, FF, G, bx); pg8::EpiBf16<2> E{Ub, FF};
        pg8::gemm_phase<pg8::EpiBf16<2>, pg8::StaticOrder, true, true>(lds, g, S, E); }
    SEAM(14);
    if (IN(15)) { { pg8::Gemm g{Ub, Wt_down + (size_t)DM * FF, MP, DM, 4096, 4096}; pg8::StaticOrder S; S.init(MP, DM, G, bx); pg8::EpiResH<false> E{Xb, XH, DM, ALPHA};
          pg8::gemm_phase<pg8::EpiResH<false>, pg8::StaticOrder, true, true>(lds, g, S, E); }
        { pg8::Gemm g{Ub, Wt_down + (size_t)DM * FF, M, DM, 512, 4096}; pg8::SplitOrder S{MP / 256, DM / 256, 8, 512, 256, bx, G}; pg8::EpiPart E{PARTb, MP / 256, 512, MS, DM};
          pg8::gemm_phase<pg8::EpiPart, pg8::SplitOrder, true, true>(lds, g, S, E); } }
    SEAM(15);
    if (IN(16)) LN_PHASE(ln_ffn_g + DM, ln_ffn_b + DM, (const float*)nullptr, 8, true);
#undef IN
#undef SEAM
}

#ifndef MK_MULTI
#define MK_MULTI 0
#endif
extern "C" void kernel_launch(void* const* d_in, const int* in_sizes, int n_in, void* d_out, int out_size, void* d_ws, size_t ws_size, hipStream_t stream) {
    static int grid = 0;
    if (grid == 0) {
        if (n_in != 23 || (size_t)out_size != O_END || ws_size < W_END2) { fprintf(stderr, "kernel_launch: unexpected shapes: n_in %d out %d ws %zu (need %zu)\n", n_in, out_size, ws_size, (size_t)W_END); grid = -1; return; }
        int dev = 0, cus = 0, per_cu = 0;
        hipGetDevice(&dev); hipDeviceGetAttribute(&cus, hipDeviceAttributeMultiprocessorCount, dev);
        if (hipFuncSetAttribute((const void*)fwd, hipFuncAttributeMaxDynamicSharedMemorySize, LDS_BYTES) != hipSuccess) { fprintf(stderr, "kernel_launch: hipFuncSetAttribute failed\n"); grid = -1; return; }
        if (hipOccupancyMaxActiveBlocksPerMultiprocessor(&per_cu, (const void*)fwd, 512, LDS_BYTES) != hipSuccess || per_cu < 1) { fprintf(stderr, "kernel_launch: occupancy query says %d\n", per_cu); per_cu = 1; }
        (void)hipGetLastError();
        grid = cus;
    }
    if (grid < 0) return;
    if (hipMemsetAsync(d_ws, 0, 65536, stream) != hipSuccess) { fprintf(stderr, "kernel_launch: memset failed\n"); return; }
    Args a{};
    for (int i = 0; i < 23; ++i) a.in[i] = (const float*)d_in[i];
    a.out = (float*)d_out; a.ws = (unsigned char*)d_ws;
#if MK_MULTI
    for (int p = 0; p < NPH; ++p) { a.ph_lo = p; a.ph_hi = p + 1; hipLaunchKernelGGL(fwd, dim3(grid), dim3(512), LDS_BYTES, stream, a); }
#else
    a.ph_lo = 0; a.ph_hi = NPH;
    void* kargs[] = {&a};
    hipError_t e = hipLaunchCooperativeKernel((const void*)fwd, dim3(grid), dim3(512), kargs, LDS_BYTES, stream);
    if (e != hipSuccess) fprintf(stderr, "cooperative launch failed: %s (grid %d)\n", hipGetErrorString(e), grid);
#endif
}
```
